# Optimizing an MI355X kernel written in HIP

```python
import math
import jax, jax.numpy as jnp
from jax import lax
import numpy as np

D_MODEL = 1024
BATCH = 4
SEQ = 8192
DEPTH = 1
DEC_BATCH = 2
DEC_SEQ = 16384
PAST_LEN = 128

MIX_WIDTH = D_MODEL
ATTN_WIDTH = MIX_WIDTH // 2
A_HEADS = 4
V_DIM = ATTN_WIDTH // A_HEADS
QK_DIM = V_DIM // 2
ATTN_QK_WIDTH = A_HEADS * 2 * QK_DIM
HGRN_WIDTH = MIX_WIDTH - ATTN_WIDTH
HGRN_HEADS = 4
HGRN_DK = HGRN_WIDTH // HGRN_HEADS
HGRN_DV = HGRN_WIDTH // HGRN_HEADS
D_FF = 4 * D_MODEL
N_BUCKETS = 32
MAX_DISTANCE = 128
Q_BLOCK = 128
CHUNK = 64
EPS = 1e-6
SPLIT_SIZES = (ATTN_QK_WIDTH, ATTN_QK_WIDTH, ATTN_WIDTH,
               HGRN_WIDTH, HGRN_WIDTH, HGRN_WIDTH, HGRN_WIDTH, HGRN_WIDTH)
SPLIT_POINTS = tuple(int(v) for v in np.cumsum(SPLIT_SIZES)[:-1])
PROJ_WIDTH = int(sum(SPLIT_SIZES))

kernel_name = "hymba_diffattn_hgrn2_encoder"


def rms_norm(x, w):
    xf = x.astype(jnp.float32)
    xf = xf * lax.rsqrt(jnp.mean(xf * xf, axis=-1, keepdims=True) + EPS)
    return (xf * w.astype(jnp.float32)).astype(x.dtype)


def t5_bucket(rel):
    nb = N_BUCKETS // 2
    max_exact = nb // 2
    ret = jnp.where(rel > 0, nb, 0)
    n = jnp.abs(rel)
    nf = jnp.maximum(n, 1).astype(jnp.float32)
    large = max_exact + (jnp.log(nf / max_exact) / math.log(MAX_DISTANCE / max_exact)
                         * (nb - max_exact)).astype(jnp.int32)
    large = jnp.minimum(large, nb - 1)
    return ret + jnp.where(n < max_exact, n, large)


def diff_attention(q, k, v, lam, rel_bias):
    B, S = q.shape[0], q.shape[1]
    nblk = S // Q_BLOCK
    scale = QK_DIM ** -0.5
    k_pos = jnp.arange(S)
    qb = q.reshape(B, nblk, Q_BLOCK, A_HEADS, 2, QK_DIM).transpose(1, 0, 2, 3, 4, 5)
    starts = jnp.arange(nblk) * Q_BLOCK

    def block(args):
        q_blk, start = args
        q_pos = start + jnp.arange(Q_BLOCK)
        bucket = t5_bucket(k_pos[None, :] - q_pos[:, None])
        bias = jnp.take(rel_bias, bucket, axis=0)
        bias = jnp.transpose(bias, (2, 0, 1)).astype(jnp.float32)
        logits = jnp.einsum('bqhcd,bkhcd->bhcqk', q_blk, k).astype(jnp.float32) * scale
        logits = logits + bias[None, :, None]
        p = jax.nn.softmax(logits, axis=-1)
        w = p[:, :, 0] - lam * p[:, :, 1]
        return jnp.einsum('bhqk,bkhd->bqhd', w, v)

    out = lax.map(block, (qb, starts))
    return out.transpose(1, 0, 2, 3, 4).reshape(B, S, A_HEADS, V_DIM)


def gla_chunkwise(q, k, v, log_f):
    B, H, S, K = q.shape
    V = v.shape[-1]
    N = S // CHUNK
    q = q.reshape(B, H, N, CHUNK, K)
    k = k.reshape(B, H, N, CHUNK, K)
    v = v.reshape(B, H, N, CHUNK, V)
    b = jnp.cumsum(log_f.reshape(B, H, N, CHUNK, K), axis=3)
    b_last = b[:, :, :, -1:, :]
    q_t = q * jnp.exp(b)
    k_t = k * jnp.exp(-b)
    mask = jnp.tril(jnp.ones((CHUNK, CHUNK), dtype=jnp.float32))
    A = jnp.einsum('bhnck,bhnsk->bhncs', q_t, k_t) * mask
    o_intra = jnp.einsum('bhncs,bhnsv->bhncv', A, v)
    dS = jnp.einsum('bhnck,bhncv->bhnkv', k * jnp.exp(b_last - b), v)
    decay = jnp.exp(b_last[:, :, :, 0, :])

    def step(s_prev, inp):
        ds_n, dec_n = inp
        return dec_n[..., None] * s_prev + ds_n, s_prev

    s0 = jnp.zeros((B, H, K, V), dtype=jnp.float32)
    _, s_prevs = lax.scan(step, s0, (jnp.moveaxis(dS, 2, 0), jnp.moveaxis(decay, 2, 0)))
    s_prevs = jnp.moveaxis(s_prevs, 0, 2)
    o_inter = jnp.einsum('bhnck,bhnkv->bhncv', q_t, s_prevs)
    return (o_intra + o_inter).reshape(B, H, S, V)


def encoder_layer(x, l, attn_norm_w, w_in, qk_norm_w, diff_lambda, diff_subln_w,
                  rel_bias, hgrn_lb, hgrn_norm_w, w_out, mlp_norm_w, w_mlp_in, w_mlp_out):
    B, S, _ = x.shape
    f32 = jnp.float32
    h = rms_norm(x, attn_norm_w[l])
    proj = h @ w_in[l]
    q_a, k_a, v_a, q_h, f_fw, f_bw, i_h, g_h = jnp.split(proj, SPLIT_POINTS, axis=-1)

    q_a = rms_norm(q_a.reshape(B, S, A_HEADS, 2, QK_DIM), qk_norm_w[l, 0])
    k_a = rms_norm(k_a.reshape(B, S, A_HEADS, 2, QK_DIM), qk_norm_w[l, 1])
    v_a = v_a.reshape(B, S, A_HEADS, V_DIM)
    lam_p = diff_lambda[l].astype(f32)
    lam_init = 0.8 - 0.6 * math.exp(-0.3 * l)
    lam = jnp.exp(jnp.sum(lam_p[0] * lam_p[1])) - jnp.exp(jnp.sum(lam_p[2] * lam_p[3])) + lam_init
    o_a = diff_attention(q_a, k_a, v_a, lam, rel_bias)
    o_a = (rms_norm(o_a, diff_subln_w[l]) * (1.0 - lam_init)).astype(x.dtype)
    o_a = o_a.reshape(B, S, ATTN_WIDTH)

    def to_heads(t):
        return t.reshape(B, S, HGRN_HEADS, -1).transpose(0, 2, 1, 3)

    lb = jnp.cumsum(jax.nn.softmax(hgrn_lb.astype(f32), axis=1), axis=1)[:, l]
    qh = to_heads(jax.nn.silu(q_h.astype(f32)) * (HGRN_DK ** -0.5))
    vh = to_heads(i_h.astype(f32))

    def gates(f_raw, lb_d):
        f = lb_d + (1.0 - lb_d) * jax.nn.sigmoid(f_raw.astype(f32))
        return to_heads(1.0 - f), to_heads(jnp.log(f))

    k_fw, lf_fw = gates(f_fw, lb[0])
    k_bw, lf_bw = gates(f_bw, lb[1])
    o_fw = gla_chunkwise(qh, k_fw, vh, lf_fw)
    flip = lambda t: jnp.flip(t, axis=2)
    o_bw = flip(gla_chunkwise(flip(qh), flip(k_bw), flip(vh), flip(lf_bw)))
    o_h = (o_fw + o_bw).transpose(0, 2, 1, 3)
    o_h = rms_norm(o_h, hgrn_norm_w[l]) * jax.nn.silu(g_h.astype(f32).reshape(B, S, HGRN_HEADS, HGRN_DV))
    o_h = o_h.astype(x.dtype).reshape(B, S, HGRN_WIDTH)

    x = x + jnp.concatenate([o_a, o_h], axis=-1) @ w_out[l]

    h2 = rms_norm(x, mlp_norm_w[l])
    x = x + jnp.square(jax.nn.relu(h2 @ w_mlp_in[l])) @ w_mlp_out[l]
    return x


def encoder_trunk(x, attn_norm_w, w_in, qk_norm_w, diff_lambda, diff_subln_w,
                  rel_bias, hgrn_lb, hgrn_norm_w, w_out, mlp_norm_w, w_mlp_in, w_mlp_out):
    for l in range(DEPTH):
        x = encoder_layer(x, l, attn_norm_w, w_in, qk_norm_w, diff_lambda, diff_subln_w,
                          rel_bias, hgrn_lb, hgrn_norm_w, w_out, mlp_norm_w, w_mlp_in, w_mlp_out)
    return x


def setup_inputs(seed: int = 0) -> dict:
    key = jax.random.key(seed)
    ks = jax.random.split(key, 14)
    n = jax.random.normal
    f32 = jnp.float32
    return {
        "x_prompt": n(ks[0], (BATCH, SEQ, D_MODEL), f32),
        "x_sample": n(ks[1], (DEC_BATCH, DEC_SEQ, D_MODEL), f32),
        "attn_norm_w": 1.0 + 0.02 * n(ks[2], (DEPTH, D_MODEL), f32),
        "w_in": n(ks[3], (DEPTH, D_MODEL, PROJ_WIDTH), f32) * D_MODEL ** -0.5,
        "qk_norm_w": 1.0 + 0.02 * n(ks[4], (DEPTH, 2, QK_DIM), f32),
        "diff_lambda": 0.1 * n(ks[5], (DEPTH, 4, QK_DIM), f32),
        "diff_subln_w": 1.0 + 0.02 * n(ks[6], (DEPTH, V_DIM), f32),
        "rel_bias": 0.5 * n(ks[7], (N_BUCKETS, A_HEADS), f32),
        "hgrn_lb": 0.5 * n(ks[8], (2, DEPTH + 1, HGRN_WIDTH), f32),
        "hgrn_norm_w": 1.0 + 0.02 * n(ks[9], (DEPTH, HGRN_DV), f32),
        "w_out": n(ks[10], (DEPTH, MIX_WIDTH, D_MODEL), f32) * MIX_WIDTH ** -0.5,
        "mlp_norm_w": 1.0 + 0.02 * n(ks[11], (DEPTH, D_MODEL), f32),
        "w_mlp_in": n(ks[12], (DEPTH, D_MODEL, D_FF), f32) * D_MODEL ** -0.5,
        "w_mlp_out": n(ks[13], (DEPTH, D_FF, D_MODEL), f32) * D_FF ** -0.5,
    }


def reference(x_prompt, x_sample, attn_norm_w, w_in, qk_norm_w, diff_lambda, diff_subln_w,
              rel_bias, hgrn_lb, hgrn_norm_w, w_out, mlp_norm_w, w_mlp_in, w_mlp_out):
    y_prompt = encoder_trunk(x_prompt, attn_norm_w, w_in, qk_norm_w, diff_lambda, diff_subln_w,
                             rel_bias, hgrn_lb, hgrn_norm_w, w_out, mlp_norm_w, w_mlp_in, w_mlp_out)
    y_sample = encoder_trunk(x_sample, attn_norm_w, w_in, qk_norm_w, diff_lambda, diff_subln_w,
                             rel_bias, hgrn_lb, hgrn_norm_w, w_out, mlp_norm_w, w_mlp_in, w_mlp_out)
    return (y_prompt, y_sample)
```

```cpp
#include <hip/hip_runtime.h>
#include <hip/hip_bf16.h>
#include <hip/hip_cooperative_groups.h>
#include <cstdio>
namespace cg = cooperative_groups;

typedef unsigned short bf16_t;
using bf16 = __hip_bfloat16;
using bf16x8 = __attribute__((ext_vector_type(8))) short;
using f32x4 = __attribute__((ext_vector_type(4))) float;
#define DI __device__ __forceinline__

constexpr int NTOK = 65536;
constexpr float LOG2E = 1.4426950408889634f;
constexpr float EPSN = 1e-6f;

constexpr size_t MB = 1048576;
constexpr size_t WS_WIN = 0, WS_WOUT = 8 * MB, WS_WM1 = 10 * MB, WS_WM2 = 18 * MB;
constexpr size_t WS_H = 32 * MB;
constexpr size_t WS_BIG = 160 * MB;
constexpr size_t WS_QA = WS_BIG, WS_KA = WS_BIG + 64 * MB, WS_VAT = WS_BIG + 128 * MB, WS_QH = WS_BIG + 192 * MB,
                 WS_FFW = WS_BIG + 256 * MB, WS_FBW = WS_BIG + 320 * MB, WS_IHT = WS_BIG + 384 * MB, WS_GH = WS_BIG + 448 * MB;
constexpr size_t WS_OCAT = 672 * MB;
constexpr size_t WS_END = 800 * MB;
constexpr int LDS_BYTES = 131072 + 4096;

struct Params {
  const float* xp; const float* xs; const float* attn_norm_w; const float* w_in; const float* qk_norm_w;
  const float* diff_lambda; const float* diff_subln_w; const float* rel_bias; const float* hgrn_lb;
  const float* hgrn_norm_w; const float* w_out; const float* mlp_norm_w; const float* w_mlp_in; const float* w_mlp_out;
  float* out; unsigned char* ws; int ph_lo; int ph_hi;
};

DI unsigned cvt_pk_bf16(float lo, float hi) { unsigned r; asm("v_cvt_pk_bf16_f32 %0, %1, %2" : "=v"(r) : "v"(lo), "v"(hi)); return r; }
DI bf16_t f2bf(float x) { return (bf16_t)(cvt_pk_bf16(x, 0.f) & 0xffffu); }
DI float bf2f(bf16_t b) { return __uint_as_float(((unsigned)b) << 16); }
typedef _Float16 h16x2 __attribute__((ext_vector_type(2)));
DI unsigned pk_f16(float lo, float hi) { h16x2 v = {(_Float16)lo, (_Float16)hi}; return __builtin_bit_cast(unsigned, v); }
DI float f16lo(unsigned u) { return (float)__builtin_bit_cast(h16x2, u)[0]; }
DI float f16hi(unsigned u) { return (float)__builtin_bit_cast(h16x2, u)[1]; }
DI int opaque_tid() { int t = threadIdx.x; asm volatile("" : "+v"(t)); return t; }
DI float wave_sum(float v) {
#pragma unroll
  for (int o = 32; o > 0; o >>= 1) v += __shfl_xor(v, o);
  return v;
}
DI float wave_max(float v) {
#pragma unroll
  for (int o = 32; o > 0; o >>= 1) v = fmaxf(v, __shfl_xor(v, o));
  return v;
}
DI const float* xrow(const Params& p, int tok) { return tok < 32768 ? p.xp + (size_t)tok * 1024 : p.xs + (size_t)(tok - 32768) * 1024; }
DI void seqinfo(int tok, int& T0, int& S) {
  if (tok < 32768) { T0 = tok & ~8191; S = 8192; } else { T0 = 32768 + ((tok - 32768) & ~16383); S = 16384; }
}

DI void transpose_w(const float* __restrict__ W, int K, int N, bf16_t* __restrict__ Wt, int gtid, int gthreads) {
  const int total = (K / 8) * N;
  for (int id = gtid; id < total; id += gthreads) {
    const int kc = id / N, n = id - kc * N;
    const int rho = n & 255;
    const int act = (n & ~255) + ((rho >> 5) & 3) * 64 + (rho >> 7) * 32 + ((rho >> 2) & 3) * 8 + ((rho >> 4) & 1) * 4 + (rho & 3);
    const float* src = W + (size_t)(kc * 8) * N + act;
    float v[8];
#pragma unroll
    for (int j = 0; j < 8; ++j) v[j] = src[(size_t)j * N];
    uint4 o; o.x = cvt_pk_bf16(v[0], v[1]); o.y = cvt_pk_bf16(v[2], v[3]); o.z = cvt_pk_bf16(v[4], v[5]); o.w = cvt_pk_bf16(v[6], v[7]);
    *(uint4*)(Wt + (size_t)n * K + kc * 8) = o;
  }
}
DI void rms_row_bf16(const float* __restrict__ x, const float* __restrict__ w, bf16_t* __restrict__ o, int lane) {
  const float4* xr = (const float4*)x + lane; const float4* wr = (const float4*)w + lane;
  float4 v[4]; float s = 0.f;
#pragma unroll
  for (int j = 0; j < 4; ++j) { v[j] = xr[64 * j]; s += v[j].x * v[j].x + v[j].y * v[j].y + v[j].z * v[j].z + v[j].w * v[j].w; }
  s = wave_sum(s);
  const float rstd = rsqrtf(s * (1.f / 1024.f) + EPSN);
#pragma unroll
  for (int j = 0; j < 4; ++j) {
    const float4 ww = wr[64 * j];
    uint2 q; q.x = cvt_pk_bf16(v[j].x * rstd * ww.x, v[j].y * rstd * ww.y); q.y = cvt_pk_bf16(v[j].z * rstd * ww.z, v[j].w * rstd * ww.w);
    *(uint2*)(o + lane * 4 + 256 * j) = q;
  }
}
DI void rms_row2_bf16(const float* __restrict__ x, const float* __restrict__ w, bf16_t* __restrict__ o, int lane) {
  const float4* xr = (const float4*)x + lane; const float4* wr = (const float4*)w + lane;
  float4 v[2][4]; float s0 = 0.f, s1 = 0.f;
#pragma unroll
  for (int j = 0; j < 4; ++j) { v[0][j] = xr[64 * j]; v[1][j] = xr[256 + 64 * j]; }
#pragma unroll
  for (int j = 0; j < 4; ++j) {
    s0 += v[0][j].x * v[0][j].x + v[0][j].y * v[0][j].y + v[0][j].z * v[0][j].z + v[0][j].w * v[0][j].w;
    s1 += v[1][j].x * v[1][j].x + v[1][j].y * v[1][j].y + v[1][j].z * v[1][j].z + v[1][j].w * v[1][j].w;
  }
  s0 = wave_sum(s0); s1 = wave_sum(s1);
  const float r0 = rsqrtf(s0 * (1.f / 1024.f) + EPSN), r1 = rsqrtf(s1 * (1.f / 1024.f) + EPSN);
#pragma unroll
  for (int j = 0; j < 4; ++j) {
    const float4 ww = wr[64 * j];
    uint2 q; q.x = cvt_pk_bf16(v[0][j].x * r0 * ww.x, v[0][j].y * r0 * ww.y); q.y = cvt_pk_bf16(v[0][j].z * r0 * ww.z, v[0][j].w * r0 * ww.w);
    *(uint2*)(o + lane * 4 + 256 * j) = q;
    q.x = cvt_pk_bf16(v[1][j].x * r1 * ww.x, v[1][j].y * r1 * ww.y); q.y = cvt_pk_bf16(v[1][j].z * r1 * ww.z, v[1][j].w * r1 * ww.w);
    *(uint2*)(o + 1024 + lane * 4 + 256 * j) = q;
  }
}
DI void phase_prep(const Params& p) {
  const int tid = threadIdx.x, lane = tid & 63, wave = tid >> 6;
  if (blockIdx.x == 0 && tid == 0) *(unsigned*)(p.ws + WS_END) = 0u;
  { float* RS = (float*)(p.ws + WS_END + 8192); const int i = blockIdx.x * 512 + tid; if (i < NTOK) RS[i] = 0.f; }
  if (blockIdx.x == 1) {
    float* LB = (float*)(p.ws + WS_END + 256);
    for (int i = tid; i < 1024; i += 512) { const int dir = i >> 9, ch = i & 511; LB[i] = 1.f / (1.f + expf(p.hgrn_lb[(dir * 2 + 1) * 512 + ch] - p.hgrn_lb[(dir * 2 + 0) * 512 + ch])); }
  }
  const int gthreads = gridDim.x * 512, gtid = blockIdx.x * 512 + tid;
  transpose_w(p.w_in, 1024, 4096, (bf16_t*)(p.ws + WS_WIN), gtid, gthreads);
  transpose_w(p.w_out, 1024, 1024, (bf16_t*)(p.ws + WS_WOUT), gtid, gthreads);
  transpose_w(p.w_mlp_in, 1024, 4096, (bf16_t*)(p.ws + WS_WM1), gtid, gthreads);
  transpose_w(p.w_mlp_out, 4096, 1024, (bf16_t*)(p.ws + WS_WM2), gtid, gthreads);
  bf16_t* H = (bf16_t*)(p.ws + WS_H);
  for (int tok = (blockIdx.x * 8 + wave) * 2; tok < NTOK; tok += gridDim.x * 16) rms_row2_bf16(xrow(p, tok), p.attn_norm_w, H + (size_t)tok * 1024, lane);
}
DI void phase_norm2(const Params& p) {
  const int tid = threadIdx.x, lane = tid & 63, wave = tid >> 6;
  bf16_t* H = (bf16_t*)(p.ws + WS_H);
  for (int tok = blockIdx.x * 8 + wave; tok < NTOK; tok += gridDim.x * 8) rms_row_bf16(p.out + (size_t)tok * 1024, p.mlp_norm_w, H + (size_t)tok * 1024, lane);
}

#define LAS __attribute__((address_space(3)))
constexpr int BM = 256, BK = 64, HALF = 128, HTB = HALF * BK * 2;
DI int lds_byte(int r, int c) {
  int st = (r >> 4) * 2 + (c >> 5), rr = r & 15, cc = c & 31, ob = rr * 64 + cc * 2;
  return st * 1024 + (ob ^ (((ob >> 9) & 1) << 5));
}
DI void stage_rc(int b, int& R, int& C) {
  int st = b / 1024, sb = b % 1024, swz = sb ^ (((sb >> 9) & 1) << 5);
  R = (st >> 1) * 16 + swz / 64; C = (st & 1) * 32 + (swz % 64) / 2;
}
DI int pi256(int rho) { return ((rho >> 5) & 3) * 64 + (rho >> 7) * 32 + ((rho >> 2) & 3) * 8 + ((rho >> 4) & 1) * 4 + (rho & 3); }

template <int EPI>
DI void gemm_epilogue(f32x4 (&acc)[2][2][4][2], const int pm, const int pn, const int wr, const int wc, const int fr, const int fq, const Params& p) {
  if constexpr (EPI == 0) {
    int T0, S; seqinfo(pm * 256, T0, S);
    const int typ = pn >> 1, gi = (pn & 1) * 4 + wc;
    unsigned char* ws = p.ws;
    if (typ < 2) {
      const float* nw = p.qk_norm_w + typ * 64;
      const float mul = typ ? 1.f : 0.125f * LOG2E;
      float wv[2][8];
#pragma unroll
      for (int bj = 0; bj < 2; ++bj)
#pragma unroll
        for (int j = 0; j < 8; ++j) wv[bj][j] = nw[bj * 32 + fq * 8 + j] * mul;
      bf16_t* dst = (bf16_t*)(ws + (typ ? WS_KA : WS_QA)) + (size_t)T0 * 512 + (size_t)gi * S * 64;
#pragma unroll
      for (int ai = 0; ai < 2; ++ai)
#pragma unroll
        for (int m = 0; m < 4; ++m) {
          float ss = 0.f;
#pragma unroll
          for (int bj = 0; bj < 2; ++bj)
#pragma unroll
            for (int n = 0; n < 2; ++n)
#pragma unroll
              for (int e = 0; e < 4; ++e) { const float a = acc[ai][bj][m][n][e]; ss += a * a; }
          ss += __shfl_xor(ss, 16); ss += __shfl_xor(ss, 32);
          const float rstd = rsqrtf(ss * (1.f / 64.f) + EPSN);
          const int s = pm * 256 + ai * 128 + wr * 64 + m * 16 + fr - T0;
#pragma unroll
          for (int bj = 0; bj < 2; ++bj) {
            uint4 q;
            q.x = cvt_pk_bf16(acc[ai][bj][m][0][0] * rstd * wv[bj][0], acc[ai][bj][m][0][1] * rstd * wv[bj][1]);
            q.y = cvt_pk_bf16(acc[ai][bj][m][0][2] * rstd * wv[bj][2], acc[ai][bj][m][0][3] * rstd * wv[bj][3]);
            q.z = cvt_pk_bf16(acc[ai][bj][m][1][0] * rstd * wv[bj][4], acc[ai][bj][m][1][1] * rstd * wv[bj][5]);
            q.w = cvt_pk_bf16(acc[ai][bj][m][1][2] * rstd * wv[bj][6], acc[ai][bj][m][1][3] * rstd * wv[bj][7]);
            *(uint4*)(dst + (size_t)s * 64 + bj * 32 + fq * 8) = q;
          }
        }
    } else if (typ == 2 || typ == 6) {
      bf16_t* dst = (bf16_t*)(ws + (typ == 2 ? WS_VAT : WS_IHT)) + (size_t)T0 * 512 + (size_t)((pn & 1) * 256) * S;
      const int tbase = pm * 256 - T0 + wc * 32 + fq * 4;
#pragma unroll
      for (int ai = 0; ai < 2; ++ai)
#pragma unroll
        for (int m = 0; m < 4; ++m) {
          const int d = pi256(ai * 128 + wr * 64 + m * 16 + fr);
#pragma unroll
          for (int bj = 0; bj < 2; ++bj)
#pragma unroll
            for (int n = 0; n < 2; ++n) {
              const f32x4 a = acc[ai][bj][m][n];
              uint2 q; q.x = cvt_pk_bf16(a[0], a[1]); q.y = cvt_pk_bf16(a[2], a[3]);
              *(uint2*)(dst + (size_t)d * S + tbase + bj * 128 + n * 16) = q;
            }
        }
    } else {
      const size_t off = typ == 3 ? WS_QH : typ == 4 ? WS_FFW : typ == 5 ? WS_FBW : WS_GH;
      bf16_t* dst = (bf16_t*)(ws + off);
      const float mul = typ == 3 ? 0.08838834764831845f : 1.f;
      const bool act = (typ == 3 || typ == 7);
      if (typ == 4 || typ == 5) {
        const float* LB = (const float*)(ws + WS_END + 256) + (typ - 4) * 512 + gi * 64 + fq * 8;
        float lbv[2][8];
#pragma unroll
        for (int bj = 0; bj < 2; ++bj)
#pragma unroll
          for (int j = 0; j < 8; ++j) lbv[bj][j] = LB[bj * 32 + j];
#pragma unroll
        for (int ai = 0; ai < 2; ++ai)
#pragma unroll
          for (int m = 0; m < 4; ++m) {
            const int row = pm * 256 + ai * 128 + wr * 64 + m * 16 + fr;
#pragma unroll
            for (int bj = 0; bj < 2; ++bj) {
              float v[8];
#pragma unroll
              for (int n = 0; n < 2; ++n)
#pragma unroll
                for (int e = 0; e < 4; ++e) {
                  const float a = acc[ai][bj][m][n][e], lb = lbv[bj][n * 4 + e];
                  const float sg = __builtin_amdgcn_rcpf(1.f + __expf(-a));
                  v[n * 4 + e] = __logf(lb + (1.f - lb) * sg);
                }
              uint4 q; q.x = pk_f16(v[0], v[1]); q.y = pk_f16(v[2], v[3]); q.z = pk_f16(v[4], v[5]); q.w = pk_f16(v[6], v[7]);
              *(uint4*)(dst + (size_t)row * 512 + gi * 64 + bj * 32 + fq * 8) = q;
            }
          }
      } else
#pragma unroll
      for (int ai = 0; ai < 2; ++ai)
#pragma unroll
        for (int m = 0; m < 4; ++m) {
          const int row = pm * 256 + ai * 128 + wr * 64 + m * 16 + fr;
#pragma unroll
          for (int bj = 0; bj < 2; ++bj) {
            float v[8];
#pragma unroll
            for (int n = 0; n < 2; ++n)
#pragma unroll
              for (int e = 0; e < 4; ++e) { float a = acc[ai][bj][m][n][e]; if (act) a = a * mul * __builtin_amdgcn_rcpf(1.f + __expf(-a)); v[n * 4 + e] = a; }
            uint4 q; q.x = cvt_pk_bf16(v[0], v[1]); q.y = cvt_pk_bf16(v[2], v[3]); q.z = cvt_pk_bf16(v[4], v[5]); q.w = cvt_pk_bf16(v[6], v[7]);
            *(uint4*)(dst + (size_t)row * 512 + gi * 64 + bj * 32 + fq * 8) = q;
          }
        }
    }
  } else if constexpr (EPI == 1) {
    const int col = pn * 256 + wc * 64 + fq * 8;
    float wv[2][8];
#pragma unroll
    for (int bj = 0; bj < 2; ++bj)
#pragma unroll
      for (int j = 0; j < 8; ++j) wv[bj][j] = p.mlp_norm_w[col + bj * 32 + j];
    bf16_t* H = (bf16_t*)(p.ws + WS_H);
    float* RS = (float*)(p.ws + WS_END + 8192);
#pragma unroll
    for (int ai = 0; ai < 2; ++ai)
#pragma unroll
      for (int m = 0; m < 4; ++m) {
        const int row = pm * 256 + ai * 128 + wr * 64 + m * 16 + fr;
        const float* xr = xrow(p, row) + col;
        float* orow = p.out + (size_t)row * 1024 + col;
        float ss = 0.f;
#pragma unroll
        for (int bj = 0; bj < 2; ++bj) {
          float v[8];
#pragma unroll
          for (int n = 0; n < 2; ++n) {
            const float4 x = *(const float4*)(xr + bj * 32 + n * 4);
            const f32x4 a = acc[ai][bj][m][n];
            float4 o; o.x = x.x + a[0]; o.y = x.y + a[1]; o.z = x.z + a[2]; o.w = x.w + a[3];
            *(float4*)(orow + bj * 32 + n * 4) = o;
            ss += o.x * o.x + o.y * o.y + o.z * o.z + o.w * o.w;
            v[n * 4 + 0] = o.x * wv[bj][n * 4 + 0]; v[n * 4 + 1] = o.y * wv[bj][n * 4 + 1]; v[n * 4 + 2] = o.z * wv[bj][n * 4 + 2]; v[n * 4 + 3] = o.w * wv[bj][n * 4 + 3];
          }
          uint4 q; q.x = cvt_pk_bf16(v[0], v[1]); q.y = cvt_pk_bf16(v[2], v[3]); q.z = cvt_pk_bf16(v[4], v[5]); q.w = cvt_pk_bf16(v[6], v[7]);
          *(uint4*)(H + (size_t)row * 1024 + col + bj * 32) = q;
        }
        ss += __shfl_xor(ss, 16); ss += __shfl_xor(ss, 32);
        if (fq == 0) unsafeAtomicAdd(RS + row, ss);
      }
  } else if constexpr (EPI == 3) {
#pragma unroll
    for (int ai = 0; ai < 2; ++ai)
#pragma unroll
      for (int m = 0; m < 4; ++m) {
        const int row = pm * 256 + ai * 128 + wr * 64 + m * 16 + fr;
        const int col = pn * 256 + wc * 64 + fq * 8;
        const float* xr = p.out + (size_t)row * 1024 + col;
        float* orow = p.out + (size_t)row * 1024 + col;
#pragma unroll
        for (int bj = 0; bj < 2; ++bj)
#pragma unroll
          for (int n = 0; n < 2; ++n) {
            const float4 x = *(const float4*)(xr + bj * 32 + n * 4);
            const f32x4 a = acc[ai][bj][m][n];
            float4 o; o.x = x.x + a[0]; o.y = x.y + a[1]; o.z = x.z + a[2]; o.w = x.w + a[3];
            *(float4*)(orow + bj * 32 + n * 4) = o;
          }
      }
  } else {
    bf16_t* hid = (bf16_t*)(p.ws + WS_BIG);
#pragma unroll
    for (int ai = 0; ai < 2; ++ai)
#pragma unroll
      for (int m = 0; m < 4; ++m) {
        const int row = pm * 256 + ai * 128 + wr * 64 + m * 16 + fr;
        const float r2 = __builtin_amdgcn_rcpf(((const float*)(p.ws + WS_END + 8192))[row] * (1.f / 1024.f) + EPSN);
#pragma unroll
        for (int bj = 0; bj < 2; ++bj) {
          float v[8];
#pragma unroll
          for (int n = 0; n < 2; ++n)
#pragma unroll
            for (int e = 0; e < 4; ++e) { const float a = fmaxf(acc[ai][bj][m][n][e], 0.f); v[n * 4 + e] = a * a * r2; }
          uint4 q; q.x = cvt_pk_bf16(v[0], v[1]); q.y = cvt_pk_bf16(v[2], v[3]); q.z = cvt_pk_bf16(v[4], v[5]); q.w = cvt_pk_bf16(v[6], v[7]);
          *(uint4*)(hid + (size_t)row * 4096 + pn * 256 + wc * 64 + bj * 32 + fq * 8) = q;
        }
      }
  }
}

template <int EPI>
DI void phase_gemm(const Params& p, const bf16_t* Ag, const bf16_t* Btg, const int N, const int K) {
  extern __shared__ __attribute__((aligned(16))) char shm_raw[];
  LAS unsigned char* lds = (LAS unsigned char*)shm_raw;
  const int tid = opaque_tid(), wid = __builtin_amdgcn_readfirstlane(tid >> 6), lane = tid & 63, wr = wid >> 2, wc = wid & 3, fr = lane & 15, fq = lane >> 4;
  const int nt = K / BK, nN = N / 256, nunits = 256 * nN, G = gridDim.x;
  unsigned voff[2];
#pragma unroll
  for (int i = 0; i < 2; ++i) { int R, C; stage_rc(tid * 16 + i * 8192, R, C); voff[i] = (unsigned)(R * K + C) * 2u; }
  const size_t kstep = (size_t)(BK * 2);
  const size_t hstep = (size_t)HALF * K * 2;
  const size_t tstep = 2 * hstep;
  const unsigned ldsw = (unsigned)wid * 1024u;
  const int aoff = lds_byte(wr * 64 + fr, fq * 8), boff = lds_byte(wc * 32 + fr, fq * 8);
#define PG8_SA(b, h) (((b) * 2 + (h)) * HTB)
#define PG8_SB(b, h) ((4 + (b) * 2 + (h)) * HTB)
#define PG8_STAGE(bufoff, gbase) do { _Pragma("unroll") for (int _i = 0; _i < 2; ++_i) \
    __builtin_amdgcn_global_load_lds((const unsigned*)((const char*)(gbase) + voff[_i]), (LAS unsigned*)(lds + (bufoff) + ldsw + _i * 8192), 16, 0, 0); } while (0)
#define PG8_LDA(dst, b, h) do { _Pragma("unroll") for (int m = 0; m < 4; ++m) _Pragma("unroll") for (int k = 0; k < 2; ++k) dst[m][k] = *(const LAS bf16x8*)(lds + PG8_SA(b, h) + aoff + m * 2048 + k * 1024); } while (0)
#define PG8_LDB(dst, b, h) do { _Pragma("unroll") for (int n = 0; n < 2; ++n) _Pragma("unroll") for (int k = 0; k < 2; ++k) dst[n][k] = *(const LAS bf16x8*)(lds + PG8_SB(b, h) + boff + n * 2048 + k * 1024); } while (0)
#define PG8_MMA(ai, bj, At, Bq) do { __builtin_amdgcn_s_setprio(1); _Pragma("unroll") for (int m = 0; m < 4; ++m) _Pragma("unroll") for (int n = 0; n < 2; ++n) _Pragma("unroll") for (int k = 0; k < 2; ++k) \
    acc[ai][bj][m][n] = __builtin_amdgcn_mfma_f32_16x16x32_bf16(Bq[n][k], At[m][k], acc[ai][bj][m][n], 0, 0, 0); __builtin_amdgcn_s_setprio(0); } while (0)
#define PG8_WAIT_V(n) asm volatile("s_waitcnt vmcnt(" #n ")" ::: "memory")
#define PG8_WAIT_L(n) asm volatile("s_waitcnt lgkmcnt(" #n ")" ::: "memory")
#define PG8_BAR __builtin_amdgcn_s_barrier()
#define PG8_SCHED __builtin_amdgcn_sched_barrier(0)
  const int xcd = blockIdx.x & 7, jloc = blockIdx.x >> 3, CP = nN < 8 ? nN : 8, RP = 32 / CP, cblocks = nN / CP;
  const int jr = jloc / CP, jc = jloc - jr * CP;
#define UNIT_PTRS(u, pmv, pnv, pa, pb) do { const int _i = (u) >> 8, _br = _i / cblocks, _bc = _i - _br * cblocks; \
    pmv = 32 * xcd + _br * RP + jr; pnv = _bc * CP + jc; \
    const char* _ha = (const char*)Ag + (size_t)pmv * tstep; const char* _wb = (const char*)Btg + (size_t)pnv * tstep; \
    const bool _sw = (EPI == 0) && (((pnv >> 1) & 3) == 2); pa = _sw ? _wb : _ha; pb = _sw ? _ha : _wb; } while (0)
  int ui = 0;
  int u = blockIdx.x;
  if (u >= nunits) return;
  int pm, pn; const char* cA; const char* cB;
  UNIT_PTRS(u, pm, pn, cA, cB);
  f32x4 acc[2][2][4][2];
#pragma unroll
  for (int a = 0; a < 2; ++a)
#pragma unroll
    for (int b = 0; b < 2; ++b)
#pragma unroll
      for (int m = 0; m < 4; ++m)
#pragma unroll
        for (int n = 0; n < 2; ++n) acc[a][b][m][n] = (f32x4){0.f, 0.f, 0.f, 0.f};
  bf16x8 At[4][2], B0[2][2], B1[2][2];
  PG8_STAGE(PG8_SB(0, 0), cB); PG8_STAGE(PG8_SA(0, 0), cA); PG8_STAGE(PG8_SB(0, 1), cB + hstep); PG8_STAGE(PG8_SA(0, 1), cA + hstep);
  if (wr == 1) PG8_BAR;
  PG8_WAIT_V(4); PG8_BAR;
  PG8_STAGE(PG8_SB(1, 0), cB + kstep); PG8_STAGE(PG8_SA(1, 0), cA + kstep); PG8_STAGE(PG8_SB(1, 1), cB + hstep + kstep);
  PG8_WAIT_V(6); PG8_BAR;
  for (;;) {
    const int un = u + G;
    const bool has_next = un < nunits;
    int pm2 = pm, pn2 = pn; const char* nA = cA; const char* nB = cB;
    if (has_next) { UNIT_PTRS(un, pm2, pn2, nA, nB); }
    for (int t = 0; t < nt; t += 2) {
      const bool last = (t == nt - 2);
      const char* a1 = cA + (size_t)(t + 1) * kstep;
      const char* a2 = last ? nA : cA + (size_t)(t + 2) * kstep; const char* b2 = last ? nB : cB + (size_t)(t + 2) * kstep;
      const char* a3 = a2 + kstep; const char* b3 = b2 + kstep;
      PG8_LDB(B0, 0, 0); PG8_SCHED; PG8_LDA(At, 0, 0); PG8_STAGE(PG8_SA(1, 1), a1 + hstep);
      PG8_WAIT_L(8); PG8_BAR; PG8_WAIT_L(0); PG8_MMA(0, 0, At, B0); PG8_BAR; PG8_SCHED;
      PG8_LDB(B1, 0, 1); PG8_STAGE(PG8_SB(0, 0), b2);
      PG8_BAR; PG8_WAIT_L(0); PG8_MMA(0, 1, At, B1); PG8_BAR;
      PG8_LDA(At, 0, 1); PG8_STAGE(PG8_SA(0, 0), a2);
      PG8_BAR; PG8_WAIT_L(0); PG8_MMA(1, 0, At, B0); PG8_BAR; PG8_SCHED;
      PG8_STAGE(PG8_SB(0, 1), b2 + hstep);
      PG8_WAIT_V(6); PG8_BAR; PG8_MMA(1, 1, At, B1); PG8_BAR;
      PG8_LDB(B0, 1, 0); PG8_SCHED; PG8_LDA(At, 1, 0); PG8_STAGE(PG8_SA(0, 1), a2 + hstep);
      PG8_WAIT_L(8); PG8_BAR; PG8_WAIT_L(0); PG8_MMA(0, 0, At, B0); PG8_BAR; PG8_SCHED;
      PG8_LDB(B1, 1, 1); PG8_STAGE(PG8_SB(1, 0), b3);
      PG8_BAR; PG8_WAIT_L(0); PG8_MMA(0, 1, At, B1); PG8_BAR;
      PG8_LDA(At, 1, 1); PG8_STAGE(PG8_SA(1, 0), a3);
      PG8_BAR; PG8_WAIT_L(0); PG8_MMA(1, 0, At, B0); PG8_BAR; PG8_SCHED;
      PG8_STAGE(PG8_SB(1, 1), b3 + hstep);
      PG8_WAIT_V(6); PG8_BAR; PG8_MMA(1, 1, At, B1); PG8_BAR;
    }
    gemm_epilogue<EPI>(acc, pm, pn, wr, wc, fr, fq, p);
    if (!has_next) break;
#pragma unroll
    for (int a = 0; a < 2; ++a)
#pragma unroll
      for (int b = 0; b < 2; ++b)
#pragma unroll
        for (int m = 0; m < 4; ++m)
#pragma unroll
          for (int n = 0; n < 2; ++n) acc[a][b][m][n] = (f32x4){0.f, 0.f, 0.f, 0.f};
    u = un; pm = pm2; pn = pn2; cA = nA; cB = nB; ++ui;
  }
  PG8_WAIT_V(0);
  if (wr == 0) PG8_BAR;
  PG8_BAR;
#undef PG8_SA
#undef PG8_SB
#undef PG8_STAGE
#undef PG8_LDA
#undef PG8_LDB
#undef PG8_MMA
#undef UNIT_PTRS
}

DI int t5_bucket(int rel) {
  const int n = rel < 0 ? -rel : rel;
  int b;
  if (n < 8) b = n;
  else { int lg = 8 + (int)(logf((float)n / 8.f) / 2.772588722239781f * 8.f); b = lg < 15 ? lg : 15; }
  return (rel > 0 ? 16 : 0) + b;
}

DI void mixer_consts(const Params& p, float* sC) {
  if (threadIdx.x < 64) {
    const int l = threadIdx.x;
    const float wq = wave_max(fabsf(p.qk_norm_w[l])), wk = wave_max(fabsf(p.qk_norm_w[64 + l]));
    const float d1 = wave_sum(p.diff_lambda[l] * p.diff_lambda[64 + l]), d2 = wave_sum(p.diff_lambda[128 + l] * p.diff_lambda[192 + l]);
    if (l == 0) { sC[0] = expf(d1) - expf(d2) + 0.2f; sC[1] = 8.f * wq * wk * 1.01f; }
  }
  __syncthreads();
}

using f32x16 = __attribute__((ext_vector_type(16))) float;
typedef float f32x2 __attribute__((ext_vector_type(2)));
typedef __bf16 bf16x2_t __attribute__((ext_vector_type(2)));
typedef unsigned u32x4 __attribute__((ext_vector_type(4)));
DI unsigned pk_bf16(float lo, float hi) { f32x2 v = {lo, hi}; return __builtin_bit_cast(unsigned, __builtin_convertvector(v, bf16x2_t)); }
#define MFMA32(a, b, c) __builtin_amdgcn_mfma_f32_32x32x16_bf16((a), (b), (c), 0, 0, 0)

DI void attn_item(const Params& p, const int item) {
  extern __shared__ __attribute__((aligned(16))) char shm_raw[];
  LAS unsigned char* lds = (LAS unsigned char*)shm_raw;
  int h, qb, S, T0;
  if (item < 1024) { h = (item >> 7) & 3; qb = item & 127; S = 16384; T0 = 32768 + (item >> 9) * 16384; }
  else { const int it = item - 1024; h = (it >> 6) & 3; qb = it & 63; S = 8192; T0 = (it >> 8) * 8192; }
  const int tid = opaque_tid(), wid = __builtin_amdgcn_readfirstlane(tid >> 6), lane = tid & 63, r = lane & 31, hl = lane >> 5;
  const int qs = wid & 3, c = wid >> 2;
  float* sTab = (float*)(shm_raw + 131072);
  float* sC = sTab + 320;
  __syncthreads();
  mixer_consts(p, sC);
  const float lam = sC[0];
  float maxb = -1e30f;
  for (int b = 0; b < 32; ++b) maxb = fmaxf(maxb, p.rel_bias[b * 4 + h]);
  const float Mshift = sC[1] + maxb;
  if (tid < 257) sTab[tid] = (p.rel_bias[t5_bucket(tid - 128) * 4 + h] - Mshift) * LOG2E;
  const float cL = (p.rel_bias[15 * 4 + h] - Mshift) * LOG2E, cR = (p.rel_bias[31 * 4 + h] - Mshift) * LOG2E;

  const int q0 = qb * 128, qpos = q0 + qs * 32 + r;
  const bf16_t* QAp = (const bf16_t*)(p.ws + WS_QA) + (size_t)T0 * 512 + (size_t)((h * 2 + c) * S) * 64;
  bf16x8 Qf[4];
#pragma unroll
  for (int ks = 0; ks < 4; ++ks) Qf[ks] = *(const bf16x8*)(QAp + (size_t)qpos * 64 + ks * 16 + hl * 8);

  const int j0 = (wid & 3) * 4;
  const char* sbase; unsigned soff[2]; size_t cstride, inc;
  if (wid < 4) {
    const int cc = j0 >> 3;
    sbase = (const char*)((const bf16_t*)(p.ws + WS_KA) + (size_t)T0 * 512 + (size_t)((h * 2 + cc) * S) * 64) + (size_t)(8 * (j0 & 7)) * 128;
    cstride = 1024; inc = 8192;
#pragma unroll
    for (int e = 0; e < 2; ++e) { const int R = 8 * ((j0 & 7) + e) + (lane >> 3), g = (lane & 7) ^ ((R >> 1) & 7); soff[e] = (unsigned)((lane >> 3) * 128 + g * 16); }
  } else {
    sbase = (const char*)((const bf16_t*)(p.ws + WS_VAT) + (size_t)T0 * 512 + (size_t)(h * 128 + 8 * j0) * S);
    cstride = (size_t)16 * S; inc = 128;
#pragma unroll
    for (int e = 0; e < 2; ++e) { const int R = 8 * (j0 + e) + (lane >> 3), g = (lane & 7) ^ ((R >> 1) & 7); soff[e] = (unsigned)((lane >> 3) * S * 2 + g * 16); }
  }
  const int stg_base = (wid < 4 ? 0 : 49152) + (wid & 3) * 4096;
#define ATT_STAGE(t, ring) do { const char* _b = sbase + (size_t)(t) * inc; _Pragma("unroll") for (int _i = 0; _i < 4; ++_i) \
    __builtin_amdgcn_global_load_lds((const unsigned*)(_b + _i * cstride + soff[_i & 1]), (LAS unsigned*)(lds + stg_base + (ring) * 16384 + _i * 1024), 16, 0, 0); } while (0)

  const int kap = (r & 19) | ((r & 4) << 1) | ((r & 8) >> 1);
  const int swk = (kap >> 1) & 7, swv = (r >> 1) & 7;
  int koff[4], voff[4];
#pragma unroll
  for (int s = 0; s < 4; ++s) { koff[s] = c * 8192 + kap * 128 + (((2 * s + hl) ^ swk) << 4); voff[s] = 49152 + r * 128 + (((2 * s + hl) ^ swv) << 4); }

  f32x16 O[4];
#pragma unroll
  for (int db = 0; db < 4; ++db)
#pragma unroll
    for (int i = 0; i < 16; ++i) O[db][i] = 0.f;
  const int tL = q0 >= 192 ? (q0 - 128) >> 6 : 0, tR = (q0 + 256) >> 6;
  const float fL = __builtin_amdgcn_exp2f(cL), fR = __builtin_amdgcn_exp2f(-cR);
  const f32x16 Zf = {0.f, 0.f, 0.f, 0.f, 0.f, 0.f, 0.f, 0.f, 0.f, 0.f, 0.f, 0.f, 0.f, 0.f, 0.f, 0.f};
  float lsum = 0.f;
  const int nT = S >> 6;
  bf16x8 kf[2][4];
  f32x16 X[2];
  bf16x8 pf[4];
#define ATT_LDK(ring) do { _Pragma("unroll") for (int kh = 0; kh < 2; ++kh) _Pragma("unroll") for (int ks = 0; ks < 4; ++ks) \
    kf[kh][ks] = *(const LAS bf16x8*)(lds + (ring) * 16384 + kh * 4096 + koff[ks]); } while (0)
#define ATT_QK(tt) do { const int k0 = (tt) << 6; \
    const bool far = ((tt) < tL) || ((tt) >= tR); \
    if ((tt) == tL && tL > 0) lsum *= fL; \
    if ((tt) == tR) lsum *= fR; \
    if (far) { _Pragma("unroll") for (int kh = 0; kh < 2; ++kh) X[kh] = MFMA32(kf[kh][0], Qf[0], Zf); } \
    else { _Pragma("unroll") for (int kh = 0; kh < 2; ++kh) { f32x16 bi; \
        _Pragma("unroll") for (int i = 0; i < 16; ++i) { \
          const int key = k0 + 32 * kh + (i & 3) + 4 * ((i >> 2) & 1) + 8 * hl + 16 * (i >> 3); \
          int rel = key - qpos; rel = rel < -128 ? -128 : (rel > 128 ? 128 : rel); bi[i] = sTab[rel + 128]; } \
        X[kh] = MFMA32(kf[kh][0], Qf[0], bi); } } \
    _Pragma("unroll") for (int ks = 1; ks < 4; ++ks) _Pragma("unroll") for (int kh = 0; kh < 2; ++kh) X[kh] = MFMA32(kf[kh][ks], Qf[ks], X[kh]); } while (0)
#define ATT_SM(kh, dst) do { _Pragma("unroll") for (int i = 0; i < 16; ++i) { X[kh][i] = __builtin_amdgcn_exp2f(X[kh][i]); lsum += X[kh][i]; } \
    _Pragma("unroll") for (int s2 = 0; s2 < 2; ++s2) { u32x4 pk; \
      pk[0] = pk_bf16(X[kh][8 * s2 + 0], X[kh][8 * s2 + 1]); pk[1] = pk_bf16(X[kh][8 * s2 + 2], X[kh][8 * s2 + 3]); \
      pk[2] = pk_bf16(X[kh][8 * s2 + 4], X[kh][8 * s2 + 5]); pk[3] = pk_bf16(X[kh][8 * s2 + 6], X[kh][8 * s2 + 7]); \
      dst[2 * (kh) + s2] = __builtin_bit_cast(bf16x8, pk); } } while (0)

  if (wid >= 4) __builtin_amdgcn_s_setprio(1);
  ATT_STAGE(0, 0); ATT_STAGE(1, 1);
  if (wid < 4) { ATT_STAGE(2, 2); PG8_WAIT_V(8); }
  PG8_BAR;
  ATT_LDK(0);
  ATT_QK(0);
  PG8_WAIT_L(0); PG8_BAR;
  if (wid < 4) ATT_STAGE(3, 0);
  ATT_SM(0, pf); ATT_SM(1, pf);
  if (wid < 4) PG8_WAIT_V(8);
  PG8_BAR;
  ATT_LDK(1);
  int m0 = 0, m1 = 1, m2 = 2;
  for (int t = 0; t < nT - 1; ++t) {
    PG8_WAIT_L(0); PG8_WAIT_V(4); PG8_BAR;
    { const int tk = t + 4 < nT ? t + 4 : nT - 1, tv = t + 2 < nT ? t + 2 : nT - 1; if (wid < 4) ATT_STAGE(tk, m1); else ATT_STAGE(tv, m2); }
    const LAS unsigned char* vb = lds + m0 * 16384;
    if ((t == tL && tL > 0) || t == tR) {
      const float f = t == tR ? fR : fL;
#pragma unroll
      for (int db = 0; db < 4; ++db)
#pragma unroll
        for (int i = 0; i < 16; ++i) O[db][i] *= f;
    }
    bf16x8 vfA[4][2], vfB[4][2];
#pragma unroll
    for (int db = 0; db < 4; ++db)
#pragma unroll
      for (int s = 0; s < 2; ++s) vfA[db][s] = *(const LAS bf16x8*)(vb + db * 4096 + voff[s]);
    ATT_QK(t + 1);
    PG8_SCHED;
#pragma unroll
    for (int db = 0; db < 4; ++db)
#pragma unroll
      for (int s = 0; s < 2; ++s) vfB[db][s] = *(const LAS bf16x8*)(vb + db * 4096 + voff[s + 2]);
    bf16x8 pfN[4];
#pragma unroll
    for (int s = 0; s < 2; ++s)
#pragma unroll
      for (int db = 0; db < 4; ++db) O[db] = MFMA32(vfA[db][s], pf[s], O[db]);
    ATT_SM(0, pfN);
    PG8_SCHED;
    ATT_LDK(m2);
#pragma unroll
    for (int s = 0; s < 2; ++s)
#pragma unroll
      for (int db = 0; db < 4; ++db) O[db] = MFMA32(vfB[db][s], pf[s + 2], O[db]);
    ATT_SM(1, pfN);
    PG8_SCHED;
#pragma unroll
    for (int s = 0; s < 4; ++s) pf[s] = pfN[s];
    { const int mm = m0; m0 = m1; m1 = m2; m2 = mm; }
  }
  PG8_WAIT_V(0); PG8_BAR;
  {
    const LAS unsigned char* vb = lds + m0 * 16384;
    if ((nT - 1 == tL && tL > 0) || nT - 1 == tR) {
      const float f = nT - 1 == tR ? fR : fL;
#pragma unroll
      for (int db = 0; db < 4; ++db)
#pragma unroll
        for (int i = 0; i < 16; ++i) O[db][i] *= f;
    }
#pragma unroll
    for (int db = 0; db < 4; ++db)
#pragma unroll
      for (int s = 0; s < 4; ++s) { const bf16x8 vf = *(const LAS bf16x8*)(vb + db * 4096 + voff[s]); O[db] = MFMA32(vf, pf[s], O[db]); }
  }
#undef ATT_LDK
#undef ATT_QK
#undef ATT_SM
  __builtin_amdgcn_s_setprio(0);
  PG8_WAIT_V(0); PG8_BAR;
  lsum += __shfl_xor(lsum, 32);
  const float sc = (c ? lam : 1.f) / lsum;
  float* ex = (float*)shm_raw;
  if (c == 1) {
#pragma unroll
    for (int db = 0; db < 4; ++db)
#pragma unroll
      for (int i = 0; i < 16; ++i) ex[(qs * 128 + 32 * db + (i & 3) + 8 * (i >> 2) + 4 * hl) * 32 + r] = O[db][i] * sc;
  }
  __syncthreads();
  if (c == 0) {
    float ss = 0.f;
#pragma unroll
    for (int db = 0; db < 4; ++db)
#pragma unroll
      for (int i = 0; i < 16; ++i) { const float o = O[db][i] * sc - ex[(qs * 128 + 32 * db + (i & 3) + 8 * (i >> 2) + 4 * hl) * 32 + r]; O[db][i] = o; ss += o * o; }
    ss += __shfl_xor(ss, 32);
    const float rstd = rsqrtf(ss * (1.f / 128.f) + EPSN) * 0.8f;
    bf16_t* dst = (bf16_t*)(p.ws + WS_OCAT) + (size_t)(T0 + qpos) * 1024 + h * 128;
#pragma unroll
    for (int db = 0; db < 4; ++db)
#pragma unroll
      for (int i4 = 0; i4 < 4; ++i4) {
        const int d0 = 32 * db + 8 * i4 + 4 * hl;
        const float4 w = *(const float4*)(p.diff_subln_w + d0);
        uint2 q; q.x = pk_bf16(O[db][4 * i4] * rstd * w.x, O[db][4 * i4 + 1] * rstd * w.y); q.y = pk_bf16(O[db][4 * i4 + 2] * rstd * w.z, O[db][4 * i4 + 3] * rstd * w.w);
        *(uint2*)(dst + d0) = q;
      }
  }
#undef ATT_STAGE
}

#define MFMA16(a, b, c) __builtin_amdgcn_mfma_f32_16x16x32_bf16((a), (b), (c), 0, 0, 0)
typedef short s16x4 __attribute__((ext_vector_type(4)));
constexpr int HG_QT = 0, HG_KT = 17408, HG_KST = 34816, HG_AM = 53248, HG_DEC = 62464, HG_SEG = 62976, HG_VT = 67584;

DI void hgrn_item(const Params& p, const int ch) {
  extern __shared__ __attribute__((aligned(16))) char shm_raw[];
  LAS unsigned char* lds = (LAS unsigned char*)shm_raw;
  int hh, dir, S, T0;
  if (ch < 16) { hh = (ch >> 1) & 3; dir = ch & 1; S = 16384; T0 = 32768 + (ch >> 3) * 16384; }
  else { const int cc = ch - 16; hh = (cc >> 1) & 3; dir = cc & 1; S = 8192; T0 = (cc >> 3) * 8192; }
  const int tid = opaque_tid(), wid = __builtin_amdgcn_readfirstlane(tid >> 6), lane = tid & 63, l15 = lane & 15, fq = lane >> 4;
  const int kp = tid & 63, seg = wid, k0 = 2 * kp;
  const int N = S >> 6;
  const int cstart = dir ? 8 * seg + 7 : 8 * seg, cstep = dir ? -1 : 1;
  const unsigned* Fg = (const unsigned*)((const bf16_t*)(p.ws + (dir ? WS_FBW : WS_FFW)) + (size_t)T0 * 512 + hh * 128) + kp;
  const unsigned* Qg = (const unsigned*)((const bf16_t*)(p.ws + WS_QH) + (size_t)T0 * 512 + hh * 128) + kp;
  const bf16_t* Vg = (const bf16_t*)(p.ws + WS_IHT) + (size_t)T0 * 512 + (size_t)(hh * 128) * S;
  bf16_t* Od = (bf16_t*)p.out + (size_t)dir * NTOK * 512 + (size_t)T0 * 512 + hh * 128 + wid * 16 + fq * 4;
  f32x4 St[8];
#pragma unroll
  for (int i = 0; i < 8; ++i) St[i] = (f32x4){0.f, 0.f, 0.f, 0.f};
  unsigned fraw[8], qraw[8];
  const char* vsrc[2];
#pragma unroll
  for (int i = 0; i < 2; ++i) { const int R = 8 * (2 * wid + i) + (lane >> 3), g = (lane & 7) ^ ((R >> 1) & 7); vsrc[i] = (const char*)(Vg + (size_t)R * S) + g * 16; }
#define HG_LOAD(n, vb) do { const int _t0 = (n) * 64; \
    _Pragma("unroll") for (int j = 0; j < 8; ++j) { const size_t _o = (size_t)(_t0 + cstart + j * cstep) * 256; fraw[j] = Fg[_o]; qraw[j] = Qg[_o]; } \
    _Pragma("unroll") for (int i = 0; i < 2; ++i) __builtin_amdgcn_global_load_lds((const unsigned*)(vsrc[i] + (size_t)_t0 * 2), (LAS unsigned*)(lds + HG_VT + (vb) * 16384 + (2 * wid + i) * 1024), 16, 0, 0); } while (0)
  __syncthreads();
  HG_LOAD(dir ? N - 1 : 0, 0);
  const int vrd = (16 * wid + l15) * 128;
  const int swv = (l15 >> 1) & 7;
  for (int it = 0; it < N; ++it) {
    const int n = dir ? N - 1 - it : it, t0 = n * 64;
    float lf0[8], lf1[8], gk0[8], gk1[8];
    float run0 = 0.f, run1 = 0.f;
#pragma unroll
    for (int j = 0; j < 8; ++j) {
      const float f0 = f16lo(fraw[j]), f1 = f16hi(fraw[j]);
      gk0[j] = 1.f - __expf(f0); gk1[j] = 1.f - __expf(f1);
      run0 += f0; run1 += f1; lf0[j] = run0; lf1[j] = run1;
    }
    { float2 rr; rr.x = run0; rr.y = run1; *(float2*)(shm_raw + HG_SEG + (seg * 128 + k0) * 4) = rr; }
    __syncthreads();
    float off0 = 0.f, off1 = 0.f, bl0 = 0.f, bl1 = 0.f;
#pragma unroll
    for (int s2 = 0; s2 < 8; ++s2) {
      const float2 tt = *(const float2*)(shm_raw + HG_SEG + (s2 * 128 + k0) * 4);
      bl0 += tt.x; bl1 += tt.y;
      const bool before = dir ? (s2 > seg) : (s2 < seg);
      off0 += before ? tt.x : 0.f; off1 += before ? tt.y : 0.f;
    }
    float ks0[8], ks1[8];
#pragma unroll
    for (int j = 0; j < 8; ++j) {
      const float b0 = lf0[j] + off0, b1 = lf1[j] + off1;
      const float q0 = __uint_as_float(qraw[j] << 16), q1 = __uint_as_float(qraw[j] & 0xffff0000u);
      const int c = cstart + j * cstep;
      *(unsigned*)(shm_raw + HG_QT + c * 272 + k0 * 2) = pk_bf16(q0 * __expf(b0), q1 * __expf(b1));
      *(unsigned*)(shm_raw + HG_KT + c * 272 + k0 * 2) = pk_bf16(gk0[j] * __expf(-b0), gk1[j] * __expf(-b1));
      ks0[j] = gk0[j] * __expf(bl0 - b0); ks1[j] = gk1[j] * __expf(bl1 - b1);
    }
    {
      uint4 w0, w1;
      w0.x = pk_bf16(dir ? ks0[7] : ks0[0], dir ? ks0[6] : ks0[1]); w0.y = pk_bf16(dir ? ks0[5] : ks0[2], dir ? ks0[4] : ks0[3]);
      w0.z = pk_bf16(dir ? ks0[3] : ks0[4], dir ? ks0[2] : ks0[5]); w0.w = pk_bf16(dir ? ks0[1] : ks0[6], dir ? ks0[0] : ks0[7]);
      w1.x = pk_bf16(dir ? ks1[7] : ks1[0], dir ? ks1[6] : ks1[1]); w1.y = pk_bf16(dir ? ks1[5] : ks1[2], dir ? ks1[4] : ks1[3]);
      w1.z = pk_bf16(dir ? ks1[3] : ks1[4], dir ? ks1[2] : ks1[5]); w1.w = pk_bf16(dir ? ks1[1] : ks1[6], dir ? ks1[0] : ks1[7]);
      *(uint4*)(shm_raw + HG_KST + k0 * 144 + seg * 16) = w0;
      *(uint4*)(shm_raw + HG_KST + (k0 + 1) * 144 + seg * 16) = w1;
    }
    if (seg == 0) { float2 dd; dd.x = __expf(bl0); dd.y = __expf(bl1); *(float2*)(shm_raw + HG_DEC + k0 * 4) = dd; }
    PG8_WAIT_V(0);
    __syncthreads();
    if (it + 1 < N) HG_LOAD(dir ? N - 2 - it : it + 1, (it + 1) & 1);
    {
      const int sb = wid >> 1;
#pragma unroll
      for (int cbi = 0; cbi < 2; ++cbi) {
        const int cb = (wid & 1) * 2 + cbi;
        f32x4 acc = (f32x4){0.f, 0.f, 0.f, 0.f};
#pragma unroll
        for (int ks = 0; ks < 4; ++ks) {
          const bf16x8 A = *(const LAS bf16x8*)(lds + HG_KT + (16 * sb + l15) * 272 + ks * 64 + fq * 16);
          const bf16x8 B = *(const LAS bf16x8*)(lds + HG_QT + (16 * cb + l15) * 272 + ks * 64 + fq * 16);
          acc = MFMA16(A, B, acc);
        }
        const int s0 = 16 * sb + 4 * fq, cc = 16 * cb + l15;
        float m[4];
#pragma unroll
        for (int e = 0; e < 4; ++e) { const bool keep = dir ? (s0 + e >= cc) : (s0 + e <= cc); m[e] = keep ? acc[e] : 0.f; }
        uint2 q; q.x = pk_bf16(m[0], m[1]); q.y = pk_bf16(m[2], m[3]);
        *(uint2*)(shm_raw + HG_AM + cc * 144 + s0 * 2) = q;
      }
    }
    __syncthreads();
    bf16x8 vf[2];
#pragma unroll
    for (int st = 0; st < 2; ++st) vf[st] = *(const LAS bf16x8*)(lds + HG_VT + (it & 1) * 16384 + vrd + (((4 * st + fq) ^ swv) << 4));
    bf16x8 Sb[4];
#pragma unroll
    for (int m = 0; m < 4; ++m) {
      u32x4 pk;
      pk[0] = pk_bf16(St[2 * m][0], St[2 * m][1]); pk[1] = pk_bf16(St[2 * m][2], St[2 * m][3]);
      pk[2] = pk_bf16(St[2 * m + 1][0], St[2 * m + 1][1]); pk[3] = pk_bf16(St[2 * m + 1][2], St[2 * m + 1][3]);
      Sb[m] = __builtin_bit_cast(bf16x8, pk);
    }
#pragma unroll
    for (int cb = 0; cb < 4; ++cb) {
      f32x4 acc = (f32x4){0.f, 0.f, 0.f, 0.f};
#pragma unroll
      for (int st = 0; st < 2; ++st) {
        const bf16x8 B = *(const LAS bf16x8*)(lds + HG_AM + (16 * cb + l15) * 144 + st * 64 + fq * 16);
        acc = MFMA16(vf[st], B, acc);
      }
#pragma unroll
      for (int m = 0; m < 4; ++m) {
        const s16x4 lo = *(const LAS s16x4*)(lds + HG_QT + (16 * cb + l15) * 272 + (32 * m + 4 * fq) * 2);
        const s16x4 hi = *(const LAS s16x4*)(lds + HG_QT + (16 * cb + l15) * 272 + (32 * m + 16 + 4 * fq) * 2);
        const bf16x8 B = __builtin_shufflevector(lo, hi, 0, 1, 2, 3, 4, 5, 6, 7);
        acc = MFMA16(Sb[m], B, acc);
      }
      uint2 o; o.x = pk_bf16(acc[0], acc[1]); o.y = pk_bf16(acc[2], acc[3]);
      *(uint2*)(Od + (size_t)(t0 + 16 * cb + l15) * 512) = o;
    }
#pragma unroll
    for (int kb = 0; kb < 8; ++kb) {
      const float4 dc = *(const float4*)(shm_raw + HG_DEC + (16 * kb + 4 * fq) * 4);
      f32x4 s = St[kb];
      s[0] *= dc.x; s[1] *= dc.y; s[2] *= dc.z; s[3] *= dc.w;
#pragma unroll
      for (int st = 0; st < 2; ++st) {
        const bf16x8 A = *(const LAS bf16x8*)(lds + HG_KST + (16 * kb + l15) * 144 + st * 64 + fq * 16);
        s = MFMA16(A, vf[st], s);
      }
      St[kb] = s;
    }
    __syncthreads();
  }
#undef HG_LOAD
}

DI void phase_mixer(const Params& p) {
  extern __shared__ __attribute__((aligned(16))) char shm_raw[];
  int* sItem = (int*)(shm_raw + 131072 + 2048);
  unsigned* ctr = (unsigned*)(p.ws + WS_END);
  for (;;) {
    __syncthreads();
    if (threadIdx.x == 0) *sItem = (int)atomicAdd(ctr, 1u);
    __syncthreads();
    const int it = *sItem;
    if (it >= 48 + 2048) break;
    if (it < 48) hgrn_item(p, it); else attn_item(p, it - 48);
  }
}

DI void phase_combine(const Params& p) {
  const int lane = threadIdx.x & 63, wave = threadIdx.x >> 6;
  const unsigned* ofw = (const unsigned*)p.out; const unsigned* obw = (const unsigned*)((const bf16_t*)p.out + (size_t)NTOK * 512);
  const unsigned* GH = (const unsigned*)(p.ws + WS_GH);
  bf16_t* OC = (bf16_t*)(p.ws + WS_OCAT);
  const float w0 = p.hgrn_norm_w[lane * 2], w1 = p.hgrn_norm_w[lane * 2 + 1];
  for (int tok = blockIdx.x * 8 + wave; tok < NTOK; tok += gridDim.x * 8) {
    unsigned a[4], b[4], g[4];
#pragma unroll
    for (int hh = 0; hh < 4; ++hh) { const size_t idx = ((size_t)tok * 512 + hh * 128 + lane * 2) >> 1; a[hh] = ofw[idx]; b[hh] = obw[idx]; g[hh] = GH[idx]; }
#pragma unroll
    for (int hh = 0; hh < 4; ++hh) {
      const float o0 = __uint_as_float(a[hh] << 16) + __uint_as_float(b[hh] << 16), o1 = __uint_as_float(a[hh] & 0xffff0000u) + __uint_as_float(b[hh] & 0xffff0000u);
      const float ss = wave_sum(o0 * o0 + o1 * o1);
      const float rstd = rsqrtf(ss * (1.f / 128.f) + EPSN);
      const float g0 = __uint_as_float(g[hh] << 16), g1 = __uint_as_float(g[hh] & 0xffff0000u);
      *(unsigned*)(OC + (size_t)tok * 1024 + 512 + hh * 128 + lane * 2) = cvt_pk_bf16(o0 * rstd * w0 * g0, o1 * rstd * w1 * g1);
    }
  }
}

#define XB_TMO      128
#define XB_XCNT(j)  (256  + 64 * (j))
#define XB_XSUB(j)  (1280 + 64 * (j))
#define XB_XGEN(j)  (2304 + 64 * (j))
#define XB_TOP      3328
#define XB_TOPGEN   3392
#define XCD_BAR_WORDS 3456
#define XB_SPIN_CAP (1u << 20)
constexpr size_t WS_BAR = WS_END + 8192 + 262144 + 256;
DI unsigned xb_ld(unsigned* p)              { return __hip_atomic_load(p, __ATOMIC_RELAXED, __HIP_MEMORY_SCOPE_AGENT); }
DI unsigned xb_add(unsigned* p, unsigned v) { return __hip_atomic_fetch_add(p, v, __ATOMIC_RELAXED, __HIP_MEMORY_SCOPE_AGENT); }
DI unsigned xb_xcc_id() { return (unsigned)__builtin_amdgcn_s_getreg((3 << 11) | 20) & 0xFu; }
#define XB_SPIN(cond, bar) do { unsigned _sp = 0; while (cond) { __builtin_amdgcn_s_sleep(1); \
    if ((++_sp & 255u) == 0u) { if (xb_ld(&(bar)[XB_TMO])) break; if (_sp > XB_SPIN_CAP) { atomicAdd(&(bar)[XB_TMO], 1u); break; } } } } while (0)
struct XcdBarrier { unsigned* bar; unsigned x; volatile LAS unsigned* st; };
DI XcdBarrier xcd_barrier_post(unsigned* bar, volatile LAS unsigned* st) {
  XcdBarrier b; b.bar = bar; b.x = xb_xcc_id(); b.st = st;
  if (threadIdx.x == 0) (void)xb_add(&bar[XB_XCNT(b.x)], 1u);
  return b;
}
DI void xcd_barrier_complete(unsigned* bar, unsigned x, unsigned& nloc, unsigned& nx) {
  const unsigned G = gridDim.x * gridDim.y * gridDim.z;
  unsigned sum, cnt, mine, sp = 0u;
  for (;;) {
    sum = 0u; cnt = 0u; mine = 0u;
#pragma unroll
    for (unsigned j = 0; j < 16; ++j) { const unsigned c = xb_ld(&bar[XB_XCNT(j)]); sum += c; cnt += (c > 0u) ? 1u : 0u; mine = (j == x) ? c : mine; }
    if (sum == G) break;
    __builtin_amdgcn_s_sleep(1);
    if ((++sp & 255u) == 0u) { if (xb_ld(&bar[XB_TMO])) break; if (sp > XB_SPIN_CAP) { atomicAdd(&bar[XB_TMO], 1u); break; } }
  }
  nloc = mine > 0u ? mine : 1u; nx = cnt > 0u ? cnt : 1u;
}
DI void xcd_barrier(const XcdBarrier& b) {
  asm volatile("s_waitcnt vmcnt(0)" ::: "memory");
  __syncthreads();
  if (threadIdx.x == 0) {
    unsigned* bar = b.bar;
    __builtin_amdgcn_s_waitcnt(0);
    unsigned nloc = b.st[0], nx = b.st[1];
    if (nloc == 0u) { xcd_barrier_complete(bar, b.x, nloc, nx); b.st[0] = nloc; b.st[1] = nx; }
    const unsigned old = xb_add(&bar[XB_XSUB(b.x)], 1u);
    const unsigned gen = old / nloc;
    if (old + 1u == (gen + 1u) * nloc) {
      __builtin_amdgcn_fence(__ATOMIC_RELEASE, "agent");
      asm volatile("s_waitcnt vmcnt(0)" ::: "memory");
      const unsigned og = xb_add(&bar[XB_TOP], 1u);
      const unsigned tg = og / nx;
      if (og + 1u == (tg + 1u) * nx) xb_add(&bar[XB_TOPGEN], 1u);
      else XB_SPIN(xb_ld(&bar[XB_TOPGEN]) == tg, bar);
      __builtin_amdgcn_fence(__ATOMIC_ACQUIRE, "agent");
      xb_add(&bar[XB_XGEN(b.x)], 1u);
      asm volatile("s_waitcnt vmcnt(0)" ::: "memory");
    } else {
      XB_SPIN(xb_ld(&bar[XB_XGEN(b.x)]) == gen, bar);
      __builtin_amdgcn_fence(__ATOMIC_ACQUIRE, "agent");
      asm volatile("s_waitcnt vmcnt(0)" ::: "memory");
    }
  }
  __syncthreads();
}

template <int PH> DI void run_phase(const Params& p) {
  if constexpr (PH == 0) phase_prep(p);
  else if constexpr (PH == 1) phase_gemm<0>(p, (const bf16_t*)(p.ws + WS_H), (const bf16_t*)(p.ws + WS_WIN), 4096, 1024);
  else if constexpr (PH == 2) phase_mixer(p);
  else if constexpr (PH == 3) phase_combine(p);
  else if constexpr (PH == 4) phase_gemm<1>(p, (const bf16_t*)(p.ws + WS_OCAT), (const bf16_t*)(p.ws + WS_WOUT), 1024, 1024);
  else if constexpr (PH == 5) phase_norm2(p);
  else if constexpr (PH == 6) phase_gemm<2>(p, (const bf16_t*)(p.ws + WS_H), (const bf16_t*)(p.ws + WS_WM1), 4096, 1024);
  else if constexpr (PH == 7) phase_gemm<3>(p, (const bf16_t*)(p.ws + WS_BIG), (const bf16_t*)(p.ws + WS_WM2), 1024, 4096);
}
__global__ void __launch_bounds__(512, 2) mega(Params p) {
  extern __shared__ __attribute__((aligned(16))) char shm_raw[];
  cg::grid_group grid = cg::this_grid();
  volatile LAS unsigned* st = (volatile LAS unsigned*)((LAS unsigned char*)shm_raw + 131072 + 3072);
  if (threadIdx.x == 0) { st[0] = 0u; st[1] = 0u; st[2] = 0u; st[3] = 0u; }
  __syncthreads();
  if (p.ph_hi < 0) grid.sync();
  const XcdBarrier xb = xcd_barrier_post((unsigned*)(p.ws + WS_BAR), st);
  run_phase<0>(p); xcd_barrier(xb);
  run_phase<1>(p); xcd_barrier(xb);
  run_phase<2>(p); xcd_barrier(xb);
  run_phase<3>(p); xcd_barrier(xb);
  run_phase<4>(p); xcd_barrier(xb);
  run_phase<6>(p); xcd_barrier(xb);
  run_phase<7>(p);
}

extern "C" void kernel_launch(void* const* d_in, const int* in_sizes, int n_in, void* d_out, int out_size, void* d_ws, size_t ws_size, hipStream_t stream) {
  static int grid_blocks = 0;
  if (!grid_blocks) {
    int dev = 0, cus = 0, per_cu = 0;
    (void)hipGetDevice(&dev);
    (void)hipDeviceGetAttribute(&cus, hipDeviceAttributeMultiprocessorCount, dev);
    (void)hipFuncSetAttribute((const void*)mega, hipFuncAttributeMaxDynamicSharedMemorySize, LDS_BYTES);
    (void)hipOccupancyMaxActiveBlocksPerMultiprocessor(&per_cu, (const void*)mega, 512, LDS_BYTES);
    if (per_cu < 1) per_cu = 1;
    grid_blocks = cus * per_cu;
    if (grid_blocks > 256) grid_blocks = 256;
    if (grid_blocks < 256) fprintf(stderr, "expected 256 co-resident workgroups, got %d\n", grid_blocks);
    if (ws_size < WS_END + 8192 + 262144 + 32768) fprintf(stderr, "workspace too small: %zu < %zu\n", ws_size, (size_t)WS_END);
  }
  Params p{};
  p.xp = (const float*)d_in[0]; p.xs = (const float*)d_in[1]; p.attn_norm_w = (const float*)d_in[2]; p.w_in = (const float*)d_in[3];
  p.qk_norm_w = (const float*)d_in[4]; p.diff_lambda = (const float*)d_in[5]; p.diff_subln_w = (const float*)d_in[6]; p.rel_bias = (const float*)d_in[7];
  p.hgrn_lb = (const float*)d_in[8]; p.hgrn_norm_w = (const float*)d_in[9]; p.w_out = (const float*)d_in[10]; p.mlp_norm_w = (const float*)d_in[11];
  p.w_mlp_in = (const float*)d_in[12]; p.w_mlp_out = (const float*)d_in[13];
  p.out = (float*)d_out; p.ws = (unsigned char*)d_ws;
  p.ph_lo = 0; p.ph_hi = 7;
  (void)hipMemsetAsync((unsigned char*)d_ws + WS_BAR, 0, XCD_BAR_WORDS * 4, stream);
  void* args[] = {&p};
  hipError_t e = hipLaunchCooperativeKernel((const void*)mega, dim3(grid_blocks), dim3(512), args, LDS_BYTES, stream);
  if (e != hipSuccess) fprintf(stderr, "cooperative launch failed: %s (grid %d)\n", hipGetErrorString(e), grid_blocks);
}
```

```cpp
#include <hip/hip_runtime.h>
#include <hip/hip_bf16.h>
#include <hip/hip_cooperative_groups.h>
#include <cstdio>
namespace cg = cooperative_groups;

typedef unsigned short bf16_t;
using bf16 = __hip_bfloat16;
using bf16x8 = __attribute__((ext_vector_type(8))) short;
using f32x4 = __attribute__((ext_vector_type(4))) float;
#define DI __device__ __forceinline__

constexpr int NTOK = 65536;
constexpr float LOG2E = 1.4426950408889634f;
constexpr float EPSN = 1e-6f;

constexpr size_t MB = 1048576;
constexpr size_t WS_WIN = 0, WS_WOUT = 8 * MB, WS_WM1 = 10 * MB, WS_WM2 = 18 * MB;
constexpr size_t WS_H = 32 * MB;
constexpr size_t WS_BIG = 160 * MB;
constexpr size_t WS_QA = WS_BIG, WS_KA = WS_BIG + 64 * MB, WS_VAT = WS_BIG + 128 * MB, WS_QH = WS_BIG + 192 * MB,
                 WS_FFW = WS_BIG + 256 * MB, WS_FBW = WS_BIG + 320 * MB, WS_IHT = WS_BIG + 384 * MB, WS_GH = WS_BIG + 448 * MB;
constexpr size_t WS_OCAT = 672 * MB;
constexpr size_t WS_END = 800 * MB;
constexpr int LDS_BYTES = 131072 + 4096;

struct Params {
  const float* xp; const float* xs; const float* attn_norm_w; const float* w_in; const float* qk_norm_w;
  const float* diff_lambda; const float* diff_subln_w; const float* rel_bias; const float* hgrn_lb;
  const float* hgrn_norm_w; const float* w_out; const float* mlp_norm_w; const float* w_mlp_in; const float* w_mlp_out;
  float* out; unsigned char* ws; int ph_lo; int ph_hi;
};

DI unsigned cvt_pk_bf16(float lo, float hi) { unsigned r; asm("v_cvt_pk_bf16_f32 %0, %1, %2" : "=v"(r) : "v"(lo), "v"(hi)); return r; }
DI bf16_t f2bf(float x) { return (bf16_t)(cvt_pk_bf16(x, 0.f) & 0xffffu); }
DI float bf2f(bf16_t b) { return __uint_as_float(((unsigned)b) << 16); }
typedef _Float16 h16x2 __attribute__((ext_vector_type(2)));
DI unsigned pk_f16(float lo, float hi) { h16x2 v = {(_Float16)lo, (_Float16)hi}; return __builtin_bit_cast(unsigned, v); }
DI float f16lo(unsigned u) { return (float)__builtin_bit_cast(h16x2, u)[0]; }
DI float f16hi(unsigned u) { return (float)__builtin_bit_cast(h16x2, u)[1]; }
DI int opaque_tid() { int t = threadIdx.x; asm volatile("" : "+v"(t)); return t; }
DI float wave_sum(float v) {
#pragma unroll
  for (int o = 32; o > 0; o >>= 1) v += __shfl_xor(v, o);
  return v;
}
DI float wave_max(float v) {
#pragma unroll
  for (int o = 32; o > 0; o >>= 1) v = fmaxf(v, __shfl_xor(v, o));
  return v;
}
DI const float* xrow(const Params& p, int tok) { return tok < 32768 ? p.xp + (size_t)tok * 1024 : p.xs + (size_t)(tok - 32768) * 1024; }
DI void seqinfo(int tok, int& T0, int& S) {
  if (tok < 32768) { T0 = tok & ~8191; S = 8192; } else { T0 = 32768 + ((tok - 32768) & ~16383); S = 16384; }
}

DI void transpose_w(const float* __restrict__ W, int K, int N, bf16_t* __restrict__ Wt, int gtid, int gthreads) {
  const int total = (K / 8) * N;
  for (int id = gtid; id < total; id += gthreads) {
    const int kc = id / N, n = id - kc * N;
    const int rho = n & 255;
    const int act = (n & ~255) + ((rho >> 5) & 3) * 64 + (rho >> 7) * 32 + ((rho >> 2) & 3) * 8 + ((rho >> 4) & 1) * 4 + (rho & 3);
    const float* src = W + (size_t)(kc * 8) * N + act;
    float v[8];
#pragma unroll
    for (int j = 0; j < 8; ++j) v[j] = src[(size_t)j * N];
    uint4 o; o.x = cvt_pk_bf16(v[0], v[1]); o.y = cvt_pk_bf16(v[2], v[3]); o.z = cvt_pk_bf16(v[4], v[5]); o.w = cvt_pk_bf16(v[6], v[7]);
    *(uint4*)(Wt + (size_t)n * K + kc * 8) = o;
  }
}
DI void rms_row_bf16(const float* __restrict__ x, const float* __restrict__ w, bf16_t* __restrict__ o, int lane) {
  const float4* xr = (const float4*)x + lane; const float4* wr = (const float4*)w + lane;
  float4 v[4]; float s = 0.f;
#pragma unroll
  for (int j = 0; j < 4; ++j) { v[j] = xr[64 * j]; s += v[j].x * v[j].x + v[j].y * v[j].y + v[j].z * v[j].z + v[j].w * v[j].w; }
  s = wave_sum(s);
  const float rstd = rsqrtf(s * (1.f / 1024.f) + EPSN);
#pragma unroll
  for (int j = 0; j < 4; ++j) {
    const float4 ww = wr[64 * j];
    uint2 q; q.x = cvt_pk_bf16(v[j].x * rstd * ww.x, v[j].y * rstd * ww.y); q.y = cvt_pk_bf16(v[j].z * rstd * ww.z, v[j].w * rstd * ww.w);
    *(uint2*)(o + lane * 4 + 256 * j) = q;
  }
}
DI void rms_row2_bf16(const float* __restrict__ x, const float* __restrict__ w, bf16_t* __restrict__ o, int lane) {
  const float4* xr = (const float4*)x + lane; const float4* wr = (const float4*)w + lane;
  float4 v[2][4]; float s0 = 0.f, s1 = 0.f;
#pragma unroll
  for (int j = 0; j < 4; ++j) { v[0][j] = xr[64 * j]; v[1][j] = xr[256 + 64 * j]; }
#pragma unroll
  for (int j = 0; j < 4; ++j) {
    s0 += v[0][j].x * v[0][j].x + v[0][j].y * v[0][j].y + v[0][j].z * v[0][j].z + v[0][j].w * v[0][j].w;
    s1 += v[1][j].x * v[1][j].x + v[1][j].y * v[1][j].y + v[1][j].z * v[1][j].z + v[1][j].w * v[1][j].w;
  }
  s0 = wave_sum(s0); s1 = wave_sum(s1);
  const float r0 = rsqrtf(s0 * (1.f / 1024.f) + EPSN), r1 = rsqrtf(s1 * (1.f / 1024.f) + EPSN);
#pragma unroll
  for (int j = 0; j < 4; ++j) {
    const float4 ww = wr[64 * j];
    uint2 q; q.x = cvt_pk_bf16(v[0][j].x * r0 * ww.x, v[0][j].y * r0 * ww.y); q.y = cvt_pk_bf16(v[0][j].z * r0 * ww.z, v[0][j].w * r0 * ww.w);
    *(uint2*)(o + lane * 4 + 256 * j) = q;
    q.x = cvt_pk_bf16(v[1][j].x * r1 * ww.x, v[1][j].y * r1 * ww.y); q.y = cvt_pk_bf16(v[1][j].z * r1 * ww.z, v[1][j].w * r1 * ww.w);
    *(uint2*)(o + 1024 + lane * 4 + 256 * j) = q;
  }
}
DI void phase_prep(const Params& p) {
  const int tid = threadIdx.x, lane = tid & 63, wave = tid >> 6;
  if (blockIdx.x == 0 && tid == 0) *(unsigned*)(p.ws + WS_END) = 0u;
  { float* RS = (float*)(p.ws + WS_END + 8192); const int i = blockIdx.x * 512 + tid; if (i < NTOK) RS[i] = 0.f; }
  if (blockIdx.x == 1) {
    float* LB = (float*)(p.ws + WS_END + 256);
    for (int i = tid; i < 1024; i += 512) { const int dir = i >> 9, ch = i & 511; LB[i] = 1.f / (1.f + expf(p.hgrn_lb[(dir * 2 + 1) * 512 + ch] - p.hgrn_lb[(dir * 2 + 0) * 512 + ch])); }
  }
  const int gthreads = gridDim.x * 512, gtid = blockIdx.x * 512 + tid;
  transpose_w(p.w_in, 1024, 4096, (bf16_t*)(p.ws + WS_WIN), gtid, gthreads);
  transpose_w(p.w_out, 1024, 1024, (bf16_t*)(p.ws + WS_WOUT), gtid, gthreads);
  transpose_w(p.w_mlp_in, 1024, 4096, (bf16_t*)(p.ws + WS_WM1), gtid, gthreads);
  transpose_w(p.w_mlp_out, 4096, 1024, (bf16_t*)(p.ws + WS_WM2), gtid, gthreads);
  bf16_t* H = (bf16_t*)(p.ws + WS_H);
  for (int tok = (blockIdx.x * 8 + wave) * 2; tok < NTOK; tok += gridDim.x * 16) rms_row2_bf16(xrow(p, tok), p.attn_norm_w, H + (size_t)tok * 1024, lane);
}
DI void phase_norm2(const Params& p) {
  const int tid = threadIdx.x, lane = tid & 63, wave = tid >> 6;
  bf16_t* H = (bf16_t*)(p.ws + WS_H);
  for (int tok = blockIdx.x * 8 + wave; tok < NTOK; tok += gridDim.x * 8) rms_row_bf16(p.out + (size_t)tok * 1024, p.mlp_norm_w, H + (size_t)tok * 1024, lane);
}

#define LAS __attribute__((address_space(3)))
constexpr int BM = 256, BK = 64, HALF = 128, HTB = HALF * BK * 2;
DI int lds_byte(int r, int c) {
  int st = (r >> 4) * 2 + (c >> 5), rr = r & 15, cc = c & 31, ob = rr * 64 + cc * 2;
  return st * 1024 + (ob ^ (((ob >> 9) & 1) << 5));
}
DI void stage_rc(int b, int& R, int& C) {
  int st = b / 1024, sb = b % 1024, swz = sb ^ (((sb >> 9) & 1) << 5);
  R = (st >> 1) * 16 + swz / 64; C = (st & 1) * 32 + (swz % 64) / 2;
}
DI int pi256(int rho) { return ((rho >> 5) & 3) * 64 + (rho >> 7) * 32 + ((rho >> 2) & 3) * 8 + ((rho >> 4) & 1) * 4 + (rho & 3); }

template <int EPI>
DI void gemm_epilogue(f32x4 (&acc)[2][2][4][2], const int pm, const int pn, const int wr, const int wc, const int fr, const int fq, const Params& p) {
  if constexpr (EPI == 0) {
    int T0, S; seqinfo(pm * 256, T0, S);
    const int typ = pn >> 1, gi = (pn & 1) * 4 + wc;
    unsigned char* ws = p.ws;
    if (typ < 2) {
      const float* nw = p.qk_norm_w + typ * 64;
      const float mul = typ ? 1.f : 0.125f * LOG2E;
      float wv[2][8];
#pragma unroll
      for (int bj = 0; bj < 2; ++bj)
#pragma unroll
        for (int j = 0; j < 8; ++j) wv[bj][j] = nw[bj * 32 + fq * 8 + j] * mul;
      bf16_t* dst = (bf16_t*)(ws + (typ ? WS_KA : WS_QA)) + (size_t)T0 * 512 + (size_t)gi * S * 64;
#pragma unroll
      for (int ai = 0; ai < 2; ++ai)
#pragma unroll
        for (int m = 0; m < 4; ++m) {
          float ss = 0.f;
#pragma unroll
          for (int bj = 0; bj < 2; ++bj)
#pragma unroll
            for (int n = 0; n < 2; ++n)
#pragma unroll
              for (int e = 0; e < 4; ++e) { const float a = acc[ai][bj][m][n][e]; ss += a * a; }
          ss += __shfl_xor(ss, 16); ss += __shfl_xor(ss, 32);
          const float rstd = rsqrtf(ss * (1.f / 64.f) + EPSN);
          const int s = pm * 256 + ai * 128 + wr * 64 + m * 16 + fr - T0;
#pragma unroll
          for (int bj = 0; bj < 2; ++bj) {
            uint4 q;
            q.x = cvt_pk_bf16(acc[ai][bj][m][0][0] * rstd * wv[bj][0], acc[ai][bj][m][0][1] * rstd * wv[bj][1]);
            q.y = cvt_pk_bf16(acc[ai][bj][m][0][2] * rstd * wv[bj][2], acc[ai][bj][m][0][3] * rstd * wv[bj][3]);
            q.z = cvt_pk_bf16(acc[ai][bj][m][1][0] * rstd * wv[bj][4], acc[ai][bj][m][1][1] * rstd * wv[bj][5]);
            q.w = cvt_pk_bf16(acc[ai][bj][m][1][2] * rstd * wv[bj][6], acc[ai][bj][m][1][3] * rstd * wv[bj][7]);
            *(uint4*)(dst + (size_t)s * 64 + bj * 32 + fq * 8) = q;
          }
        }
    } else if (typ == 2 || typ == 6) {
      bf16_t* dst = (bf16_t*)(ws + (typ == 2 ? WS_VAT : WS_IHT)) + (size_t)T0 * 512 + (size_t)((pn & 1) * 256) * S;
      const int tbase = pm * 256 - T0 + wc * 32 + fq * 4;
#pragma unroll
      for (int ai = 0; ai < 2; ++ai)
#pragma unroll
        for (int m = 0; m < 4; ++m) {
          const int d = pi256(ai * 128 + wr * 64 + m * 16 + fr);
#pragma unroll
          for (int bj = 0; bj < 2; ++bj)
#pragma unroll
            for (int n = 0; n < 2; ++n) {
              const f32x4 a = acc[ai][bj][m][n];
              uint2 q; q.x = cvt_pk_bf16(a[0], a[1]); q.y = cvt_pk_bf16(a[2], a[3]);
              *(uint2*)(dst + (size_t)d * S + tbase + bj * 128 + n * 16) = q;
            }
        }
    } else {
      const size_t off = typ == 3 ? WS_QH : typ == 4 ? WS_FFW : typ == 5 ? WS_FBW : WS_GH;
      bf16_t* dst = (bf16_t*)(ws + off);
      const float mul = typ == 3 ? 0.08838834764831845f : 1.f;
      const bool act = (typ == 3 || typ == 7);
      if (typ == 4 || typ == 5) {
        const float* LB = (const float*)(ws + WS_END + 256) + (typ - 4) * 512 + gi * 64 + fq * 8;
        float lbv[2][8];
#pragma unroll
        for (int bj = 0; bj < 2; ++bj)
#pragma unroll
          for (int j = 0; j < 8; ++j) lbv[bj][j] = LB[bj * 32 + j];
#pragma unroll
        for (int ai = 0; ai < 2; ++ai)
#pragma unroll
          for (int m = 0; m < 4; ++m) {
            const int row = pm * 256 + ai * 128 + wr * 64 + m * 16 + fr;
#pragma unroll
            for (int bj = 0; bj < 2; ++bj) {
              float v[8];
#pragma unroll
              for (int n = 0; n < 2; ++n)
#pragma unroll
                for (int e = 0; e < 4; ++e) {
                  const float a = acc[ai][bj][m][n][e], lb = lbv[bj][n * 4 + e];
                  const float sg = __builtin_amdgcn_rcpf(1.f + __expf(-a));
                  v[n * 4 + e] = __logf(lb + (1.f - lb) * sg);
                }
              uint4 q; q.x = pk_f16(v[0], v[1]); q.y = pk_f16(v[2], v[3]); q.z = pk_f16(v[4], v[5]); q.w = pk_f16(v[6], v[7]);
              *(uint4*)(dst + (size_t)row * 512 + gi * 64 + bj * 32 + fq * 8) = q;
            }
          }
      } else
#pragma unroll
      for (int ai = 0; ai < 2; ++ai)
#pragma unroll
        for (int m = 0; m < 4; ++m) {
          const int row = pm * 256 + ai * 128 + wr * 64 + m * 16 + fr;
#pragma unroll
          for (int bj = 0; bj < 2; ++bj) {
            float v[8];
#pragma unroll
            for (int n = 0; n < 2; ++n)
#pragma unroll
              for (int e = 0; e < 4; ++e) { float a = acc[ai][bj][m][n][e]; if (act) a = a * mul * __builtin_amdgcn_rcpf(1.f + __expf(-a)); v[n * 4 + e] = a; }
            uint4 q; q.x = cvt_pk_bf16(v[0], v[1]); q.y = cvt_pk_bf16(v[2], v[3]); q.z = cvt_pk_bf16(v[4], v[5]); q.w = cvt_pk_bf16(v[6], v[7]);
            *(uint4*)(dst + (size_t)row * 512 + gi * 64 + bj * 32 + fq * 8) = q;
          }
        }
    }
  } else if constexpr (EPI == 1) {
    const int col = pn * 256 + wc * 64 + fq * 8;
    float wv[2][8];
#pragma unroll
    for (int bj = 0; bj < 2; ++bj)
#pragma unroll
      for (int j = 0; j < 8; ++j) wv[bj][j] = p.mlp_norm_w[col + bj * 32 + j];
    bf16_t* H = (bf16_t*)(p.ws + WS_H);
    float* RS = (float*)(p.ws + WS_END + 8192);
#pragma unroll
    for (int ai = 0; ai < 2; ++ai)
#pragma unroll
      for (int m = 0; m < 4; ++m) {
        const int row = pm * 256 + ai * 128 + wr * 64 + m * 16 + fr;
        const float* xr = xrow(p, row) + col;
        float* orow = p.out + (size_t)row * 1024 + col;
        float ss = 0.f;
#pragma unroll
        for (int bj = 0; bj < 2; ++bj) {
          float v[8];
#pragma unroll
          for (int n = 0; n < 2; ++n) {
            const float4 x = *(const float4*)(xr + bj * 32 + n * 4);
            const f32x4 a = acc[ai][bj][m][n];
            float4 o; o.x = x.x + a[0]; o.y = x.y + a[1]; o.z = x.z + a[2]; o.w = x.w + a[3];
            *(float4*)(orow + bj * 32 + n * 4) = o;
            ss += o.x * o.x + o.y * o.y + o.z * o.z + o.w * o.w;
            v[n * 4 + 0] = o.x * wv[bj][n * 4 + 0]; v[n * 4 + 1] = o.y * wv[bj][n * 4 + 1]; v[n * 4 + 2] = o.z * wv[bj][n * 4 + 2]; v[n * 4 + 3] = o.w * wv[bj][n * 4 + 3];
          }
          uint4 q; q.x = cvt_pk_bf16(v[0], v[1]); q.y = cvt_pk_bf16(v[2], v[3]); q.z = cvt_pk_bf16(v[4], v[5]); q.w = cvt_pk_bf16(v[6], v[7]);
          *(uint4*)(H + (size_t)row * 1024 + col + bj * 32) = q;
        }
        ss += __shfl_xor(ss, 16); ss += __shfl_xor(ss, 32);
        if (fq == 0) unsafeAtomicAdd(RS + row, ss);
      }
  } else if constexpr (EPI == 3) {
#pragma unroll
    for (int ai = 0; ai < 2; ++ai)
#pragma unroll
      for (int m = 0; m < 4; ++m) {
        const int row = pm * 256 + ai * 128 + wr * 64 + m * 16 + fr;
        const int col = pn * 256 + wc * 64 + fq * 8;
        const float* xr = p.out + (size_t)row * 1024 + col;
        float* orow = p.out + (size_t)row * 1024 + col;
#pragma unroll
        for (int bj = 0; bj < 2; ++bj)
#pragma unroll
          for (int n = 0; n < 2; ++n) {
            const float4 x = *(const float4*)(xr + bj * 32 + n * 4);
            const f32x4 a = acc[ai][bj][m][n];
            float4 o; o.x = x.x + a[0]; o.y = x.y + a[1]; o.z = x.z + a[2]; o.w = x.w + a[3];
            *(float4*)(orow + bj * 32 + n * 4) = o;
          }
      }
  } else {
    bf16_t* hid = (bf16_t*)(p.ws + WS_BIG);
#pragma unroll
    for (int ai = 0; ai < 2; ++ai)
#pragma unroll
      for (int m = 0; m < 4; ++m) {
        const int row = pm * 256 + ai * 128 + wr * 64 + m * 16 + fr;
        const float r2 = __builtin_amdgcn_rcpf(((const float*)(p.ws + WS_END + 8192))[row] * (1.f / 1024.f) + EPSN);
#pragma unroll
        for (int bj = 0; bj < 2; ++bj) {
          float v[8];
#pragma unroll
          for (int n = 0; n < 2; ++n)
#pragma unroll
            for (int e = 0; e < 4; ++e) { const float a = fmaxf(acc[ai][bj][m][n][e], 0.f); v[n * 4 + e] = a * a * r2; }
          uint4 q; q.x = cvt_pk_bf16(v[0], v[1]); q.y = cvt_pk_bf16(v[2], v[3]); q.z = cvt_pk_bf16(v[4], v[5]); q.w = cvt_pk_bf16(v[6], v[7]);
          *(uint4*)(hid + (size_t)row * 4096 + pn * 256 + wc * 64 + bj * 32 + fq * 8) = q;
        }
      }
  }
}

template <int EPI>
DI void phase_gemm(const Params& p, const bf16_t* Ag, const bf16_t* Btg, const int N, const int K) {
  extern __shared__ __attribute__((aligned(16))) char shm_raw[];
  LAS unsigned char* lds = (LAS unsigned char*)shm_raw;
  const int tid = opaque_tid(), wid = __builtin_amdgcn_readfirstlane(tid >> 6), lane = tid & 63, wr = wid >> 2, wc = wid & 3, fr = lane & 15, fq = lane >> 4;
  const int nt = K / BK, nN = N / 256, nunits = 256 * nN, G = gridDim.x;
  unsigned voff[2];
#pragma unroll
  for (int i = 0; i < 2; ++i) { int R, C; stage_rc(tid * 16 + i * 8192, R, C); voff[i] = (unsigned)(R * K + C) * 2u; }
  const size_t kstep = (size_t)(BK * 2);
  const size_t hstep = (size_t)HALF * K * 2;
  const size_t tstep = 2 * hstep;
  const unsigned ldsw = (unsigned)wid * 1024u;
  const int aoff = lds_byte(wr * 64 + fr, fq * 8), boff = lds_byte(wc * 32 + fr, fq * 8);
#define PG8_SA(b, h) (((b) * 2 + (h)) * HTB)
#define PG8_SB(b, h) ((4 + (b) * 2 + (h)) * HTB)
#define PG8_STAGE(bufoff, gbase) do { _Pragma("unroll") for (int _i = 0; _i < 2; ++_i) \
    __builtin_amdgcn_global_load_lds((const unsigned*)((const char*)(gbase) + voff[_i]), (LAS unsigned*)(lds + (bufoff) + ldsw + _i * 8192), 16, 0, 0); } while (0)
#define PG8_LDA(dst, b, h) do { _Pragma("unroll") for (int m = 0; m < 4; ++m) _Pragma("unroll") for (int k = 0; k < 2; ++k) dst[m][k] = *(const LAS bf16x8*)(lds + PG8_SA(b, h) + aoff + m * 2048 + k * 1024); } while (0)
#define PG8_LDB(dst, b, h) do { _Pragma("unroll") for (int n = 0; n < 2; ++n) _Pragma("unroll") for (int k = 0; k < 2; ++k) dst[n][k] = *(const LAS bf16x8*)(lds + PG8_SB(b, h) + boff + n * 2048 + k * 1024); } while (0)
#define PG8_MMA(ai, bj, At, Bq) do { __builtin_amdgcn_s_setprio(1); _Pragma("unroll") for (int m = 0; m < 4; ++m) _Pragma("unroll") for (int n = 0; n < 2; ++n) _Pragma("unroll") for (int k = 0; k < 2; ++k) \
    acc[ai][bj][m][n] = __builtin_amdgcn_mfma_f32_16x16x32_bf16(Bq[n][k], At[m][k], acc[ai][bj][m][n], 0, 0, 0); __builtin_amdgcn_s_setprio(0); } while (0)
#define PG8_WAIT_V(n) asm volatile("s_waitcnt vmcnt(" #n ")" ::: "memory")
#define PG8_WAIT_L(n) asm volatile("s_waitcnt lgkmcnt(" #n ")" ::: "memory")
#define PG8_BAR __builtin_amdgcn_s_barrier()
#define PG8_SCHED __builtin_amdgcn_sched_barrier(0)
  const int xcd = blockIdx.x & 7, jloc = blockIdx.x >> 3, CP = nN < 8 ? nN : 8, RP = 32 / CP, cblocks = nN / CP;
  const int jr = jloc / CP, jc = jloc - jr * CP;
#define UNIT_PTRS(u, pmv, pnv, pa, pb) do { const int _i = (u) >> 8, _br = _i / cblocks, _bc = _i - _br * cblocks; \
    pmv = 32 * xcd + _br * RP + jr; pnv = _bc * CP + jc; \
    const char* _ha = (const char*)Ag + (size_t)pmv * tstep; const char* _wb = (const char*)Btg + (size_t)pnv * tstep; \
    const bool _sw = (EPI == 0) && (((pnv >> 1) & 3) == 2); pa = _sw ? _wb : _ha; pb = _sw ? _ha : _wb; } while (0)
  int ui = 0;
  int u = blockIdx.x;
  if (u >= nunits) return;
  int pm, pn; const char* cA; const char* cB;
  UNIT_PTRS(u, pm, pn, cA, cB);
  f32x4 acc[2][2][4][2];
#pragma unroll
  for (int a = 0; a < 2; ++a)
#pragma unroll
    for (int b = 0; b < 2; ++b)
#pragma unroll
      for (int m = 0; m < 4; ++m)
#pragma unroll
        for (int n = 0; n < 2; ++n) acc[a][b][m][n] = (f32x4){0.f, 0.f, 0.f, 0.f};
  bf16x8 At[4][2], B0[2][2], B1[2][2];
  PG8_STAGE(PG8_SB(0, 0), cB); PG8_STAGE(PG8_SA(0, 0), cA); PG8_STAGE(PG8_SB(0, 1), cB + hstep); PG8_STAGE(PG8_SA(0, 1), cA + hstep);
  if (wr == 1) PG8_BAR;
  PG8_WAIT_V(4); PG8_BAR;
  PG8_STAGE(PG8_SB(1, 0), cB + kstep); PG8_STAGE(PG8_SA(1, 0), cA + kstep); PG8_STAGE(PG8_SB(1, 1), cB + hstep + kstep);
  PG8_WAIT_V(6); PG8_BAR;
  for (;;) {
    const int un = u + G;
    const bool has_next = un < nunits;
    int pm2 = pm, pn2 = pn; const char* nA = cA; const char* nB = cB;
    if (has_next) { UNIT_PTRS(un, pm2, pn2, nA, nB); }
    for (int t = 0; t < nt; t += 2) {
      const bool last = (t == nt - 2);
      const char* a1 = cA + (size_t)(t + 1) * kstep;
      const char* a2 = last ? nA : cA + (size_t)(t + 2) * kstep; const char* b2 = last ? nB : cB + (size_t)(t + 2) * kstep;
      const char* a3 = a2 + kstep; const char* b3 = b2 + kstep;
      PG8_LDB(B0, 0, 0); PG8_SCHED; PG8_LDA(At, 0, 0); PG8_STAGE(PG8_SA(1, 1), a1 + hstep);
      PG8_WAIT_L(8); PG8_BAR; PG8_WAIT_L(0); PG8_MMA(0, 0, At, B0); PG8_BAR; PG8_SCHED;
      PG8_LDB(B1, 0, 1); PG8_STAGE(PG8_SB(0, 0), b2);
      PG8_BAR; PG8_WAIT_L(0); PG8_MMA(0, 1, At, B1); PG8_BAR;
      PG8_LDA(At, 0, 1); PG8_STAGE(PG8_SA(0, 0), a2);
      PG8_BAR; PG8_WAIT_L(0); PG8_MMA(1, 0, At, B0); PG8_BAR; PG8_SCHED;
      PG8_STAGE(PG8_SB(0, 1), b2 + hstep);
      PG8_WAIT_V(6); PG8_BAR; PG8_MMA(1, 1, At, B1); PG8_BAR;
      PG8_LDB(B0, 1, 0); PG8_SCHED; PG8_LDA(At, 1, 0); PG8_STAGE(PG8_SA(0, 1), a2 + hstep);
      PG8_WAIT_L(8); PG8_BAR; PG8_WAIT_L(0); PG8_MMA(0, 0, At, B0); PG8_BAR; PG8_SCHED;
      PG8_LDB(B1, 1, 1); PG8_STAGE(PG8_SB(1, 0), b3);
      PG8_BAR; PG8_WAIT_L(0); PG8_MMA(0, 1, At, B1); PG8_BAR;
      PG8_LDA(At, 1, 1); PG8_STAGE(PG8_SA(1, 0), a3);
      PG8_BAR; PG8_WAIT_L(0); PG8_MMA(1, 0, At, B0); PG8_BAR; PG8_SCHED;
      PG8_STAGE(PG8_SB(1, 1), b3 + hstep);
      PG8_WAIT_V(6); PG8_BAR; PG8_MMA(1, 1, At, B1); PG8_BAR;
    }
    gemm_epilogue<EPI>(acc, pm, pn, wr, wc, fr, fq, p);
    if (!has_next) break;
#pragma unroll
    for (int a = 0; a < 2; ++a)
#pragma unroll
      for (int b = 0; b < 2; ++b)
#pragma unroll
        for (int m = 0; m < 4; ++m)
#pragma unroll
          for (int n = 0; n < 2; ++n) acc[a][b][m][n] = (f32x4){0.f, 0.f, 0.f, 0.f};
    u = un; pm = pm2; pn = pn2; cA = nA; cB = nB; ++ui;
  }
  PG8_WAIT_V(0);
  if (wr == 0) PG8_BAR;
  PG8_BAR;
#undef PG8_SA
#undef PG8_SB
#undef PG8_STAGE
#undef PG8_LDA
#undef PG8_LDB
#undef PG8_MMA
#undef UNIT_PTRS
}

DI int t5_bucket(int rel) {
  const int n = rel < 0 ? -rel : rel;
  int b;
  if (n < 8) b = n;
  else { int lg = 8 + (int)(logf((float)n / 8.f) / 2.772588722239781f * 8.f); b = lg < 15 ? lg : 15; }
  return (rel > 0 ? 16 : 0) + b;
}

DI void mixer_consts(const Params& p, float* sC) {
  if (threadIdx.x < 64) {
    const int l = threadIdx.x;
    const float wq = wave_max(fabsf(p.qk_norm_w[l])), wk = wave_max(fabsf(p.qk_norm_w[64 + l]));
    const float d1 = wave_sum(p.diff_lambda[l] * p.diff_lambda[64 + l]), d2 = wave_sum(p.diff_lambda[128 + l] * p.diff_lambda[192 + l]);
    if (l == 0) { sC[0] = expf(d1) - expf(d2) + 0.2f; sC[1] = 8.f * wq * wk * 1.01f; }
  }
  __syncthreads();
}

using f32x16 = __attribute__((ext_vector_type(16))) float;
typedef float f32x2 __attribute__((ext_vector_type(2)));
typedef __bf16 bf16x2_t __attribute__((ext_vector_type(2)));
typedef unsigned u32x4 __attribute__((ext_vector_type(4)));
DI unsigned pk_bf16(float lo, float hi) { f32x2 v = {lo, hi}; return __builtin_bit_cast(unsigned, __builtin_convertvector(v, bf16x2_t)); }
#define MFMA32(a, b, c) __builtin_amdgcn_mfma_f32_32x32x16_bf16((a), (b), (c), 0, 0, 0)

DI void attn_item(const Params& p, const int item) {
  extern __shared__ __attribute__((aligned(16))) char shm_raw[];
  LAS unsigned char* lds = (LAS unsigned char*)shm_raw;
  int h, qb, S, T0;
  if (item < 1024) { h = (item >> 7) & 3; qb = item & 127; S = 16384; T0 = 32768 + (item >> 9) * 16384; }
  else { const int it = item - 1024; h = (it >> 6) & 3; qb = it & 63; S = 8192; T0 = (it >> 8) * 8192; }
  const int tid = opaque_tid(), wid = __builtin_amdgcn_readfirstlane(tid >> 6), lane = tid & 63, r = lane & 31, hl = lane >> 5;
  const int qs = wid & 3, c = wid >> 2;
  float* sTab = (float*)(shm_raw + 131072);
  float* sC = sTab + 320;
  __syncthreads();
  mixer_consts(p, sC);
  const float lam = sC[0];
  float maxb = -1e30f;
  for (int b = 0; b < 32; ++b) maxb = fmaxf(maxb, p.rel_bias[b * 4 + h]);
  const float Mshift = sC[1] + maxb;
  if (tid < 257) sTab[tid] = (p.rel_bias[t5_bucket(tid - 128) * 4 + h] - Mshift) * LOG2E;
  const float cL = (p.rel_bias[15 * 4 + h] - Mshift) * LOG2E, cR = (p.rel_bias[31 * 4 + h] - Mshift) * LOG2E;

  const int q0 = qb * 128, qpos = q0 + qs * 32 + r;
  const bf16_t* QAp = (const bf16_t*)(p.ws + WS_QA) + (size_t)T0 * 512 + (size_t)((h * 2 + c) * S) * 64;
  bf16x8 Qf[4];
#pragma unroll
  for (int ks = 0; ks < 4; ++ks) Qf[ks] = *(const bf16x8*)(QAp + (size_t)qpos * 64 + ks * 16 + hl * 8);

  const int j0 = (wid & 3) * 4;
  const char* sbase; unsigned soff[2]; size_t cstride, inc;
  if (wid < 4) {
    const int cc = j0 >> 3;
    sbase = (const char*)((const bf16_t*)(p.ws + WS_KA) + (size_t)T0 * 512 + (size_t)((h * 2 + cc) * S) * 64) + (size_t)(8 * (j0 & 7)) * 128;
    cstride = 1024; inc = 8192;
#pragma unroll
    for (int e = 0; e < 2; ++e) { const int R = 8 * ((j0 & 7) + e) + (lane >> 3), g = (lane & 7) ^ ((R >> 1) & 7); soff[e] = (unsigned)((lane >> 3) * 128 + g * 16); }
  } else {
    sbase = (const char*)((const bf16_t*)(p.ws + WS_VAT) + (size_t)T0 * 512 + (size_t)(h * 128 + 8 * j0) * S);
    cstride = (size_t)16 * S; inc = 128;
#pragma unroll
    for (int e = 0; e < 2; ++e) { const int R = 8 * (j0 + e) + (lane >> 3), g = (lane & 7) ^ ((R >> 1) & 7); soff[e] = (unsigned)((lane >> 3) * S * 2 + g * 16); }
  }
  const int stg_base = (wid < 4 ? 0 : 49152) + (wid & 3) * 4096;
  const __amdgpu_buffer_rsrc_t srs = __builtin_amdgcn_make_buffer_rsrc((void*)sbase, 0, 0x40000000, 0x00020000);
#define ATT_STAGE(t, ring) do { const int _so = (int)((size_t)(t) * inc); _Pragma("unroll") for (int _i = 0; _i < 4; ++_i) \
    __builtin_amdgcn_raw_ptr_buffer_load_lds(srs, (LAS void*)(lds + stg_base + (ring) * 16384 + _i * 1024), 16, (int)soff[_i & 1], _so + (int)(_i * cstride), 0, 0); } while (0)

  const int kap = (r & 19) | ((r & 4) << 1) | ((r & 8) >> 1);
  const int swk = (kap >> 1) & 7, swv = (r >> 1) & 7;
  int koff[4], voff[4];
#pragma unroll
  for (int s = 0; s < 4; ++s) { koff[s] = c * 8192 + kap * 128 + (((2 * s + hl) ^ swk) << 4); voff[s] = 49152 + r * 128 + (((2 * s + hl) ^ swv) << 4); }

  f32x16 O[4];
#pragma unroll
  for (int db = 0; db < 4; ++db)
#pragma unroll
    for (int i = 0; i < 16; ++i) O[db][i] = 0.f;
  const int tL = q0 >= 192 ? (q0 - 128) >> 6 : 0, tR = (q0 + 256) >> 6;
  const float fL = __builtin_amdgcn_exp2f(cL), fR = __builtin_amdgcn_exp2f(-cR);
  const f32x16 Zf = {0.f, 0.f, 0.f, 0.f, 0.f, 0.f, 0.f, 0.f, 0.f, 0.f, 0.f, 0.f, 0.f, 0.f, 0.f, 0.f};
  float lsum = 0.f;
  const int nT = S >> 6;
  bf16x8 kf[2][4];
  f32x16 X[2];
  bf16x8 pf[4];
#define ATT_LDK(ring) do { _Pragma("unroll") for (int kh = 0; kh < 2; ++kh) _Pragma("unroll") for (int ks = 0; ks < 4; ++ks) \
    kf[kh][ks] = *(const LAS bf16x8*)(lds + (ring) * 16384 + kh * 4096 + koff[ks]); } while (0)
#define ATT_QK(tt) do { const int k0 = (tt) << 6; \
    const bool far = ((tt) < tL) || ((tt) >= tR); \
    if ((tt) == tL && tL > 0) lsum *= fL; \
    if ((tt) == tR) lsum *= fR; \
    if (far) { _Pragma("unroll") for (int kh = 0; kh < 2; ++kh) X[kh] = MFMA32(kf[kh][0], Qf[0], Zf); } \
    else { _Pragma("unroll") for (int kh = 0; kh < 2; ++kh) { f32x16 bi; \
        _Pragma("unroll") for (int i = 0; i < 16; ++i) { \
          const int key = k0 + 32 * kh + (i & 3) + 4 * ((i >> 2) & 1) + 8 * hl + 16 * (i >> 3); \
          int rel = key - qpos; rel = rel < -128 ? -128 : (rel > 128 ? 128 : rel); bi[i] = sTab[rel + 128]; } \
        X[kh] = MFMA32(kf[kh][0], Qf[0], bi); } } \
    _Pragma("unroll") for (int ks = 1; ks < 4; ++ks) _Pragma("unroll") for (int kh = 0; kh < 2; ++kh) X[kh] = MFMA32(kf[kh][ks], Qf[ks], X[kh]); } while (0)
#define ATT_SM(kh, dst) do { _Pragma("unroll") for (int i = 0; i < 16; ++i) { X[kh][i] = __builtin_amdgcn_exp2f(X[kh][i]); lsum += X[kh][i]; } \
    _Pragma("unroll") for (int s2 = 0; s2 < 2; ++s2) { u32x4 pk; \
      pk[0] = pk_bf16(X[kh][8 * s2 + 0], X[kh][8 * s2 + 1]); pk[1] = pk_bf16(X[kh][8 * s2 + 2], X[kh][8 * s2 + 3]); \
      pk[2] = pk_bf16(X[kh][8 * s2 + 4], X[kh][8 * s2 + 5]); pk[3] = pk_bf16(X[kh][8 * s2 + 6], X[kh][8 * s2 + 7]); \
      dst[2 * (kh) + s2] = __builtin_bit_cast(bf16x8, pk); } } while (0)

  ATT_STAGE(0, 0); ATT_STAGE(1, 1);
  if (wid < 4) { ATT_STAGE(2, 2); PG8_WAIT_V(8); }
  PG8_BAR;
  ATT_LDK(0);
  ATT_QK(0);
  PG8_WAIT_L(0); PG8_BAR;
  if (wid < 4) ATT_STAGE(3, 0);
  ATT_SM(0, pf); ATT_SM(1, pf);
  if (wid < 4) PG8_WAIT_V(8);
  PG8_BAR;
  ATT_LDK(1);
  int m0 = 0, m1 = 1, m2 = 2;
  for (int t = 0; t < nT - 1; ++t) {
    PG8_WAIT_L(0); PG8_WAIT_V(4); PG8_BAR;
    { const int tk = t + 4 < nT ? t + 4 : nT - 1, tv = t + 2 < nT ? t + 2 : nT - 1; if (wid < 4) ATT_STAGE(tk, m1); else ATT_STAGE(tv, m2); }
    const LAS unsigned char* vb = lds + m0 * 16384;
    if ((t == tL && tL > 0) || t == tR) {
      const float f = t == tR ? fR : fL;
#pragma unroll
      for (int db = 0; db < 4; ++db)
#pragma unroll
        for (int i = 0; i < 16; ++i) O[db][i] *= f;
    }
    bf16x8 vfA[4][2], vfB[4][2];
#pragma unroll
    for (int db = 0; db < 4; ++db)
#pragma unroll
      for (int s = 0; s < 2; ++s) vfA[db][s] = *(const LAS bf16x8*)(vb + db * 4096 + voff[s]);
    ATT_QK(t + 1);
    PG8_SCHED;
#pragma unroll
    for (int db = 0; db < 4; ++db)
#pragma unroll
      for (int s = 0; s < 2; ++s) vfB[db][s] = *(const LAS bf16x8*)(vb + db * 4096 + voff[s + 2]);
    bf16x8 pfN[4];
#pragma unroll
    for (int s = 0; s < 2; ++s)
#pragma unroll
      for (int db = 0; db < 4; ++db) O[db] = MFMA32(vfA[db][s], pf[s], O[db]);
    ATT_SM(0, pfN);
    PG8_SCHED;
    ATT_LDK(m2);
#pragma unroll
    for (int s = 0; s < 2; ++s)
#pragma unroll
      for (int db = 0; db < 4; ++db) O[db] = MFMA32(vfB[db][s], pf[s + 2], O[db]);
    ATT_SM(1, pfN);
    PG8_SCHED;
#pragma unroll
    for (int s = 0; s < 4; ++s) pf[s] = pfN[s];
    { const int mm = m0; m0 = m1; m1 = m2; m2 = mm; }
  }
  PG8_WAIT_V(0); PG8_BAR;
  {
    const LAS unsigned char* vb = lds + m0 * 16384;
    if ((nT - 1 == tL && tL > 0) || nT - 1 == tR) {
      const float f = nT - 1 == tR ? fR : fL;
#pragma unroll
      for (int db = 0; db < 4; ++db)
#pragma unroll
        for (int i = 0; i < 16; ++i) O[db][i] *= f;
    }
#pragma unroll
    for (int db = 0; db < 4; ++db)
#pragma unroll
      for (int s = 0; s < 4; ++s) { const bf16x8 vf = *(const LAS bf16x8*)(vb + db * 4096 + voff[s]); O[db] = MFMA32(vf, pf[s], O[db]); }
  }
#undef ATT_LDK
#undef ATT_QK
#undef ATT_SM
  PG8_WAIT_V(0); PG8_BAR;
  lsum += __shfl_xor(lsum, 32);
  const float sc = (c ? lam : 1.f) / lsum;
  float* ex = (float*)shm_raw;
  if (c == 1) {
#pragma unroll
    for (int db = 0; db < 4; ++db)
#pragma unroll
      for (int i = 0; i < 16; ++i) ex[(qs * 128 + 32 * db + (i & 3) + 8 * (i >> 2) + 4 * hl) * 32 + r] = O[db][i] * sc;
  }
  __syncthreads();
  if (c == 0) {
    float ss = 0.f;
#pragma unroll
    for (int db = 0; db < 4; ++db)
#pragma unroll
      for (int i = 0; i < 16; ++i) { const float o = O[db][i] * sc - ex[(qs * 128 + 32 * db + (i & 3) + 8 * (i >> 2) + 4 * hl) * 32 + r]; O[db][i] = o; ss += o * o; }
    ss += __shfl_xor(ss, 32);
    const float rstd = rsqrtf(ss * (1.f / 128.f) + EPSN) * 0.8f;
    bf16_t* dst = (bf16_t*)(p.ws + WS_OCAT) + (size_t)(T0 + qpos) * 1024 + h * 128;
#pragma unroll
    for (int db = 0; db < 4; ++db)
#pragma unroll
      for (int i4 = 0; i4 < 4; ++i4) {
        const int d0 = 32 * db + 8 * i4 + 4 * hl;
        const float4 w = *(const float4*)(p.diff_subln_w + d0);
        uint2 q; q.x = pk_bf16(O[db][4 * i4] * rstd * w.x, O[db][4 * i4 + 1] * rstd * w.y); q.y = pk_bf16(O[db][4 * i4 + 2] * rstd * w.z, O[db][4 * i4 + 3] * rstd * w.w);
        *(uint2*)(dst + d0) = q;
      }
  }
#undef ATT_STAGE
}

#define MFMA16(a, b, c) __builtin_amdgcn_mfma_f32_16x16x32_bf16((a), (b), (c), 0, 0, 0)
typedef short s16x4 __attribute__((ext_vector_type(4)));
constexpr int HG_QT = 0, HG_KT = 17408, HG_KST = 34816, HG_AM = 53248, HG_DEC = 62464, HG_SEG = 62976, HG_VT = 67584;

DI void hgrn_item(const Params& p, const int ch) {
  extern __shared__ __attribute__((aligned(16))) char shm_raw[];
  LAS unsigned char* lds = (LAS unsigned char*)shm_raw;
  int hh, dir, S, T0;
  if (ch < 16) { hh = (ch >> 1) & 3; dir = ch & 1; S = 16384; T0 = 32768 + (ch >> 3) * 16384; }
  else { const int cc = ch - 16; hh = (cc >> 1) & 3; dir = cc & 1; S = 8192; T0 = (cc >> 3) * 8192; }
  const int tid = opaque_tid(), wid = __builtin_amdgcn_readfirstlane(tid >> 6), lane = tid & 63, l15 = lane & 15, fq = lane >> 4;
  const int kp = tid & 63, seg = wid, k0 = 2 * kp;
  const int N = S >> 6;
  const int cstart = dir ? 8 * seg + 7 : 8 * seg, cstep = dir ? -1 : 1;
  const unsigned* Fg = (const unsigned*)((const bf16_t*)(p.ws + (dir ? WS_FBW : WS_FFW)) + (size_t)T0 * 512 + hh * 128) + kp;
  const unsigned* Qg = (const unsigned*)((const bf16_t*)(p.ws + WS_QH) + (size_t)T0 * 512 + hh * 128) + kp;
  const bf16_t* Vg = (const bf16_t*)(p.ws + WS_IHT) + (size_t)T0 * 512 + (size_t)(hh * 128) * S;
  bf16_t* Od = (bf16_t*)p.out + (size_t)dir * NTOK * 512 + (size_t)T0 * 512 + hh * 128 + wid * 16 + fq * 4;
  f32x4 St[8];
#pragma unroll
  for (int i = 0; i < 8; ++i) St[i] = (f32x4){0.f, 0.f, 0.f, 0.f};
  unsigned fraw[8], qraw[8];
  const char* vsrc[2];
#pragma unroll
  for (int i = 0; i < 2; ++i) { const int R = 8 * (2 * wid + i) + (lane >> 3), g = (lane & 7) ^ ((R >> 1) & 7); vsrc[i] = (const char*)(Vg + (size_t)R * S) + g * 16; }
#define HG_LOAD(n, vb) do { const int _t0 = (n) * 64; \
    _Pragma("unroll") for (int j = 0; j < 8; ++j) { const size_t _o = (size_t)(_t0 + cstart + j * cstep) * 256; fraw[j] = Fg[_o]; qraw[j] = Qg[_o]; } \
    _Pragma("unroll") for (int i = 0; i < 2; ++i) __builtin_amdgcn_global_load_lds((const unsigned*)(vsrc[i] + (size_t)_t0 * 2), (LAS unsigned*)(lds + HG_VT + (vb) * 16384 + (2 * wid + i) * 1024), 16, 0, 0); } while (0)
  __syncthreads();
  HG_LOAD(dir ? N - 1 : 0, 0);
  const int vrd = (16 * wid + l15) * 128;
  const int swv = (l15 >> 1) & 7;
  for (int it = 0; it < N; ++it) {
    const int n = dir ? N - 1 - it : it, t0 = n * 64;
    float lf0[8], lf1[8], gk0[8], gk1[8];
    float run0 = 0.f, run1 = 0.f;
#pragma unroll
    for (int j = 0; j < 8; ++j) {
      const float f0 = f16lo(fraw[j]), f1 = f16hi(fraw[j]);
      gk0[j] = 1.f - __expf(f0); gk1[j] = 1.f - __expf(f1);
      run0 += f0; run1 += f1; lf0[j] = run0; lf1[j] = run1;
    }
    { float2 rr; rr.x = run0; rr.y = run1; *(float2*)(shm_raw + HG_SEG + (seg * 128 + k0) * 4) = rr; }
    __syncthreads();
    float off0 = 0.f, off1 = 0.f, bl0 = 0.f, bl1 = 0.f;
#pragma unroll
    for (int s2 = 0; s2 < 8; ++s2) {
      const float2 tt = *(const float2*)(shm_raw + HG_SEG + (s2 * 128 + k0) * 4);
      bl0 += tt.x; bl1 += tt.y;
      const bool before = dir ? (s2 > seg) : (s2 < seg);
      off0 += before ? tt.x : 0.f; off1 += before ? tt.y : 0.f;
    }
    float ks0[8], ks1[8];
#pragma unroll
    for (int j = 0; j < 8; ++j) {
      const float b0 = lf0[j] + off0, b1 = lf1[j] + off1;
      const float q0 = __uint_as_float(qraw[j] << 16), q1 = __uint_as_float(qraw[j] & 0xffff0000u);
      const int c = cstart + j * cstep;
      *(unsigned*)(shm_raw + HG_QT + c * 272 + k0 * 2) = pk_bf16(q0 * __expf(b0), q1 * __expf(b1));
      *(unsigned*)(shm_raw + HG_KT + c * 272 + k0 * 2) = pk_bf16(gk0[j] * __expf(-b0), gk1[j] * __expf(-b1));
      ks0[j] = gk0[j] * __expf(bl0 - b0); ks1[j] = gk1[j] * __expf(bl1 - b1);
    }
    {
      uint4 w0, w1;
      w0.x = pk_bf16(dir ? ks0[7] : ks0[0], dir ? ks0[6] : ks0[1]); w0.y = pk_bf16(dir ? ks0[5] : ks0[2], dir ? ks0[4] : ks0[3]);
      w0.z = pk_bf16(dir ? ks0[3] : ks0[4], dir ? ks0[2] : ks0[5]); w0.w = pk_bf16(dir ? ks0[1] : ks0[6], dir ? ks0[0] : ks0[7]);
      w1.x = pk_bf16(dir ? ks1[7] : ks1[0], dir ? ks1[6] : ks1[1]); w1.y = pk_bf16(dir ? ks1[5] : ks1[2], dir ? ks1[4] : ks1[3]);
      w1.z = pk_bf16(dir ? ks1[3] : ks1[4], dir ? ks1[2] : ks1[5]); w1.w = pk_bf16(dir ? ks1[1] : ks1[6], dir ? ks1[0] : ks1[7]);
      *(uint4*)(shm_raw + HG_KST + k0 * 144 + seg * 16) = w0;
      *(uint4*)(shm_raw + HG_KST + (k0 + 1) * 144 + seg * 16) = w1;
    }
    if (seg == 0) { float2 dd; dd.x = __expf(bl0); dd.y = __expf(bl1); *(float2*)(shm_raw + HG_DEC + k0 * 4) = dd; }
    PG8_WAIT_V(0);
    __syncthreads();
    if (it + 1 < N) HG_LOAD(dir ? N - 2 - it : it + 1, (it + 1) & 1);
    {
      const int sb = wid >> 1;
#pragma unroll
      for (int cbi = 0; cbi < 2; ++cbi) {
        const int cb = (wid & 1) * 2 + cbi;
        f32x4 acc = (f32x4){0.f, 0.f, 0.f, 0.f};
#pragma unroll
        for (int ks = 0; ks < 4; ++ks) {
          const bf16x8 A = *(const LAS bf16x8*)(lds + HG_KT + (16 * sb + l15) * 272 + ks * 64 + fq * 16);
          const bf16x8 B = *(const LAS bf16x8*)(lds + HG_QT + (16 * cb + l15) * 272 + ks * 64 + fq * 16);
          acc = MFMA16(A, B, acc);
        }
        const int s0 = 16 * sb + 4 * fq, cc = 16 * cb + l15;
        float m[4];
#pragma unroll
        for (int e = 0; e < 4; ++e) { const bool keep = dir ? (s0 + e >= cc) : (s0 + e <= cc); m[e] = keep ? acc[e] : 0.f; }
        uint2 q; q.x = pk_bf16(m[0], m[1]); q.y = pk_bf16(m[2], m[3]);
        *(uint2*)(shm_raw + HG_AM + cc * 144 + s0 * 2) = q;
      }
    }
    __syncthreads();
    bf16x8 vf[2];
#pragma unroll
    for (int st = 0; st < 2; ++st) vf[st] = *(const LAS bf16x8*)(lds + HG_VT + (it & 1) * 16384 + vrd + (((4 * st + fq) ^ swv) << 4));
    bf16x8 Sb[4];
#pragma unroll
    for (int m = 0; m < 4; ++m) {
      u32x4 pk;
      pk[0] = pk_bf16(St[2 * m][0], St[2 * m][1]); pk[1] = pk_bf16(St[2 * m][2], St[2 * m][3]);
      pk[2] = pk_bf16(St[2 * m + 1][0], St[2 * m + 1][1]); pk[3] = pk_bf16(St[2 * m + 1][2], St[2 * m + 1][3]);
      Sb[m] = __builtin_bit_cast(bf16x8, pk);
    }
#pragma unroll
    for (int cb = 0; cb < 4; ++cb) {
      f32x4 acc = (f32x4){0.f, 0.f, 0.f, 0.f};
#pragma unroll
      for (int st = 0; st < 2; ++st) {
        const bf16x8 B = *(const LAS bf16x8*)(lds + HG_AM + (16 * cb + l15) * 144 + st * 64 + fq * 16);
        acc = MFMA16(vf[st], B, acc);
      }
#pragma unroll
      for (int m = 0; m < 4; ++m) {
        const s16x4 lo = *(const LAS s16x4*)(lds + HG_QT + (16 * cb + l15) * 272 + (32 * m + 4 * fq) * 2);
        const s16x4 hi = *(const LAS s16x4*)(lds + HG_QT + (16 * cb + l15) * 272 + (32 * m + 16 + 4 * fq) * 2);
        const bf16x8 B = __builtin_shufflevector(lo, hi, 0, 1, 2, 3, 4, 5, 6, 7);
        acc = MFMA16(Sb[m], B, acc);
      }
      uint2 o; o.x = pk_bf16(acc[0], acc[1]); o.y = pk_bf16(acc[2], acc[3]);
      *(uint2*)(Od + (size_t)(t0 + 16 * cb + l15) * 512) = o;
    }
#pragma unroll
    for (int kb = 0; kb < 8; ++kb) {
      const float4 dc = *(const float4*)(shm_raw + HG_DEC + (16 * kb + 4 * fq) * 4);
      f32x4 s = St[kb];
      s[0] *= dc.x; s[1] *= dc.y; s[2] *= dc.z; s[3] *= dc.w;
#pragma unroll
      for (int st = 0; st < 2; ++st) {
        const bf16x8 A = *(const LAS bf16x8*)(lds + HG_KST + (16 * kb + l15) * 144 + st * 64 + fq * 16);
        s = MFMA16(A, vf[st], s);
      }
      St[kb] = s;
    }
    __syncthreads();
  }
#undef HG_LOAD
}

DI void phase_mixer(const Params& p) {
  extern __shared__ __attribute__((aligned(16))) char shm_raw[];
  int* sItem = (int*)(shm_raw + 131072 + 2048);
  unsigned* ctr = (unsigned*)(p.ws + WS_END);
  for (;;) {
    __syncthreads();
    if (threadIdx.x == 0) *sItem = (int)atomicAdd(ctr, 1u);
    __syncthreads();
    const int it = *sItem;
    if (it >= 48 + 2048) break;
    if (it < 48) hgrn_item(p, it); else attn_item(p, it - 48);
  }
}

DI void phase_combine(const Params& p) {
  const int lane = threadIdx.x & 63, wave = threadIdx.x >> 6;
  const unsigned* ofw = (const unsigned*)p.out; const unsigned* obw = (const unsigned*)((const bf16_t*)p.out + (size_t)NTOK * 512);
  const unsigned* GH = (const unsigned*)(p.ws + WS_GH);
  bf16_t* OC = (bf16_t*)(p.ws + WS_OCAT);
  const float w0 = p.hgrn_norm_w[lane * 2], w1 = p.hgrn_norm_w[lane * 2 + 1];
  for (int tok = blockIdx.x * 8 + wave; tok < NTOK; tok += gridDim.x * 8) {
    unsigned a[4], b[4], g[4];
#pragma unroll
    for (int hh = 0; hh < 4; ++hh) { const size_t idx = ((size_t)tok * 512 + hh * 128 + lane * 2) >> 1; a[hh] = ofw[idx]; b[hh] = obw[idx]; g[hh] = GH[idx]; }
#pragma unroll
    for (int hh = 0; hh < 4; ++hh) {
      const float o0 = __uint_as_float(a[hh] << 16) + __uint_as_float(b[hh] << 16), o1 = __uint_as_float(a[hh] & 0xffff0000u) + __uint_as_float(b[hh] & 0xffff0000u);
      const float ss = wave_sum(o0 * o0 + o1 * o1);
      const float rstd = rsqrtf(ss * (1.f / 128.f) + EPSN);
      const float g0 = __uint_as_float(g[hh] << 16), g1 = __uint_as_float(g[hh] & 0xffff0000u);
      *(unsigned*)(OC + (size_t)tok * 1024 + 512 + hh * 128 + lane * 2) = cvt_pk_bf16(o0 * rstd * w0 * g0, o1 * rstd * w1 * g1);
    }
  }
}

#define XB_TMO      128
#define XB_XCNT(j)  (256  + 64 * (j))
#define XB_XSUB(j)  (1280 + 64 * (j))
#define XB_XGEN(j)  (2304 + 64 * (j))
#define XB_TOP      3328
#define XB_TOPGEN   3392
#define XCD_BAR_WORDS 3456
#define XB_SPIN_CAP (1u << 20)
constexpr size_t WS_BAR = WS_END + 8192 + 262144 + 256;
DI unsigned xb_ld(unsigned* p)              { return __hip_atomic_load(p, __ATOMIC_RELAXED, __HIP_MEMORY_SCOPE_AGENT); }
DI unsigned xb_add(unsigned* p, unsigned v) { return __hip_atomic_fetch_add(p, v, __ATOMIC_RELAXED, __HIP_MEMORY_SCOPE_AGENT); }
DI unsigned xb_xcc_id() { return (unsigned)__builtin_amdgcn_s_getreg((3 << 11) | 20) & 0xFu; }
#define XB_SPIN(cond, bar) do { unsigned _sp = 0; while (cond) { __builtin_amdgcn_s_sleep(1); \
    if ((++_sp & 255u) == 0u) { if (xb_ld(&(bar)[XB_TMO])) break; if (_sp > XB_SPIN_CAP) { atomicAdd(&(bar)[XB_TMO], 1u); break; } } } } while (0)
struct XcdBarrier { unsigned* bar; unsigned x; volatile LAS unsigned* st; };
DI XcdBarrier xcd_barrier_post(unsigned* bar, volatile LAS unsigned* st) {
  XcdBarrier b; b.bar = bar; b.x = xb_xcc_id(); b.st = st;
  if (threadIdx.x == 0) (void)xb_add(&bar[XB_XCNT(b.x)], 1u);
  return b;
}
DI void xcd_barrier_complete(unsigned* bar, unsigned x, unsigned& nloc, unsigned& nx) {
  const unsigned G = gridDim.x * gridDim.y * gridDim.z;
  unsigned sum, cnt, mine, sp = 0u;
  for (;;) {
    sum = 0u; cnt = 0u; mine = 0u;
#pragma unroll
    for (unsigned j = 0; j < 16; ++j) { const unsigned c = xb_ld(&bar[XB_XCNT(j)]); sum += c; cnt += (c > 0u) ? 1u : 0u; mine = (j == x) ? c : mine; }
    if (sum == G) break;
    __builtin_amdgcn_s_sleep(1);
    if ((++sp & 255u) == 0u) { if (xb_ld(&bar[XB_TMO])) break; if (sp > XB_SPIN_CAP) { atomicAdd(&bar[XB_TMO], 1u); break; } }
  }
  nloc = mine > 0u ? mine : 1u; nx = cnt > 0u ? cnt : 1u;
}
DI void xcd_barrier(const XcdBarrier& b) {
  asm volatile("s_waitcnt vmcnt(0)" ::: "memory");
  __syncthreads();
  if (threadIdx.x == 0) {
    unsigned* bar = b.bar;
    __builtin_amdgcn_s_waitcnt(0);
    unsigned nloc = b.st[0], nx = b.st[1];
    if (nloc == 0u) { xcd_barrier_complete(bar, b.x, nloc, nx); b.st[0] = nloc; b.st[1] = nx; }
    const unsigned old = xb_add(&bar[XB_XSUB(b.x)], 1u);
    const unsigned gen = old / nloc;
    if (old + 1u == (gen + 1u) * nloc) {
      __builtin_amdgcn_fence(__ATOMIC_RELEASE, "agent");
      asm volatile("s_waitcnt vmcnt(0)" ::: "memory");
      const unsigned og = xb_add(&bar[XB_TOP], 1u);
      const unsigned tg = og / nx;
      if (og + 1u == (tg + 1u) * nx) xb_add(&bar[XB_TOPGEN], 1u);
      else XB_SPIN(xb_ld(&bar[XB_TOPGEN]) == tg, bar);
      __builtin_amdgcn_fence(__ATOMIC_ACQUIRE, "agent");
      xb_add(&bar[XB_XGEN(b.x)], 1u);
      asm volatile("s_waitcnt vmcnt(0)" ::: "memory");
    } else {
      XB_SPIN(xb_ld(&bar[XB_XGEN(b.x)]) == gen, bar);
      __builtin_amdgcn_fence(__ATOMIC_ACQUIRE, "agent");
      asm volatile("s_waitcnt vmcnt(0)" ::: "memory");
    }
  }
  __syncthreads();
}

template <int PH> DI void run_phase(const Params& p) {
  if constexpr (PH == 0) phase_prep(p);
  else if constexpr (PH == 1) phase_gemm<0>(p, (const bf16_t*)(p.ws + WS_H), (const bf16_t*)(p.ws + WS_WIN), 4096, 1024);
  else if constexpr (PH == 2) phase_mixer(p);
  else if constexpr (PH == 3) phase_combine(p);
  else if constexpr (PH == 4) phase_gemm<1>(p, (const bf16_t*)(p.ws + WS_OCAT), (const bf16_t*)(p.ws + WS_WOUT), 1024, 1024);
  else if constexpr (PH == 5) phase_norm2(p);
  else if constexpr (PH == 6) phase_gemm<2>(p, (const bf16_t*)(p.ws + WS_H), (const bf16_t*)(p.ws + WS_WM1), 4096, 1024);
  else if constexpr (PH == 7) phase_gemm<3>(p, (const bf16_t*)(p.ws + WS_BIG), (const bf16_t*)(p.ws + WS_WM2), 1024, 4096);
}
__global__ void __launch_bounds__(512, 2) mega(Params p) {
  extern __shared__ __attribute__((aligned(16))) char shm_raw[];
  cg::grid_group grid = cg::this_grid();
  volatile LAS unsigned* st = (volatile LAS unsigned*)((LAS unsigned char*)shm_raw + 131072 + 3072);
  if (threadIdx.x == 0) { st[0] = 0u; st[1] = 0u; st[2] = 0u; st[3] = 0u; }
  __syncthreads();
  if (p.ph_hi < 0) grid.sync();
  const XcdBarrier xb = xcd_barrier_post((unsigned*)(p.ws + WS_BAR), st);
  run_phase<0>(p); xcd_barrier(xb);
  run_phase<1>(p); xcd_barrier(xb);
  run_phase<2>(p); xcd_barrier(xb);
  run_phase<3>(p); xcd_barrier(xb);
  run_phase<4>(p); xcd_barrier(xb);
  run_phase<6>(p); xcd_barrier(xb);
  run_phase<7>(p);
}

extern "C" void kernel_launch(void* const* d_in, const int* in_sizes, int n_in, void* d_out, int out_size, void* d_ws, size_t ws_size, hipStream_t stream) {
  static int grid_blocks = 0;
  if (!grid_blocks) {
    int dev = 0, cus = 0, per_cu = 0;
    (void)hipGetDevice(&dev);
    (void)hipDeviceGetAttribute(&cus, hipDeviceAttributeMultiprocessorCount, dev);
    (void)hipFuncSetAttribute((const void*)mega, hipFuncAttributeMaxDynamicSharedMemorySize, LDS_BYTES);
    (void)hipOccupancyMaxActiveBlocksPerMultiprocessor(&per_cu, (const void*)mega, 512, LDS_BYTES);
    if (per_cu < 1) per_cu = 1;
    grid_blocks = cus * per_cu;
    if (grid_blocks > 256) grid_blocks = 256;
    if (grid_blocks < 256) fprintf(stderr, "expected 256 co-resident workgroups, got %d\n", grid_blocks);
    if (ws_size < WS_END + 8192 + 262144 + 32768) fprintf(stderr, "workspace too small: %zu < %zu\n", ws_size, (size_t)WS_END);
  }
  Params p{};
  p.xp = (const float*)d_in[0]; p.xs = (const float*)d_in[1]; p.attn_norm_w = (const float*)d_in[2]; p.w_in = (const float*)d_in[3];
  p.qk_norm_w = (const float*)d_in[4]; p.diff_lambda = (const float*)d_in[5]; p.diff_subln_w = (const float*)d_in[6]; p.rel_bias = (const float*)d_in[7];
  p.hgrn_lb = (const float*)d_in[8]; p.hgrn_norm_w = (const float*)d_in[9]; p.w_out = (const float*)d_in[10]; p.mlp_norm_w = (const float*)d_in[11];
  p.w_mlp_in = (const float*)d_in[12]; p.w_mlp_out = (const float*)d_in[13];
  p.out = (float*)d_out; p.ws = (unsigned char*)d_ws;
  p.ph_lo = 0; p.ph_hi = 7;
  (void)hipMemsetAsync((unsigned char*)d_ws + WS_BAR, 0, XCD_BAR_WORDS * 4, stream);
  void* args[] = {&p};
  hipError_t e = hipLaunchCooperativeKernel((const void*)mega, dim3(grid_blocks), dim3(512), args, LDS_BYTES, stream);
  if (e != hipSuccess) fprintf(stderr, "cooperative launch failed: %s (grid %d)\n", hipGetErrorString(e), grid_blocks);
}
```

```cpp
#include <hip/hip_runtime.h>
#include <hip/hip_bf16.h>
#include <hip/hip_cooperative_groups.h>
#include <cstdio>
namespace cg = cooperative_groups;

typedef unsigned short bf16_t;
using bf16 = __hip_bfloat16;
using bf16x8 = __attribute__((ext_vector_type(8))) short;
using f32x4 = __attribute__((ext_vector_type(4))) float;
#define DI __device__ __forceinline__

constexpr int NTOK = 65536;
constexpr float LOG2E = 1.4426950408889634f;
constexpr float EPSN = 1e-6f;

constexpr size_t MB = 1048576;
constexpr size_t WS_WIN = 0, WS_WOUT = 8 * MB, WS_WM1 = 10 * MB, WS_WM2 = 18 * MB;
constexpr size_t WS_H = 32 * MB;
constexpr size_t WS_BIG = 160 * MB;
constexpr size_t WS_QA = WS_BIG, WS_KA = WS_BIG + 64 * MB, WS_VAT = WS_BIG + 128 * MB, WS_QH = WS_BIG + 192 * MB,
                 WS_FFW = WS_BIG + 256 * MB, WS_FBW = WS_BIG + 320 * MB, WS_IHT = WS_BIG + 384 * MB, WS_GH = WS_BIG + 448 * MB;
constexpr size_t WS_OCAT = 672 * MB;
constexpr size_t WS_END = 800 * MB;
constexpr int LDS_BYTES = 131072 + 4096;

struct Params {
  const float* xp; const float* xs; const float* attn_norm_w; const float* w_in; const float* qk_norm_w;
  const float* diff_lambda; const float* diff_subln_w; const float* rel_bias; const float* hgrn_lb;
  const float* hgrn_norm_w; const float* w_out; const float* mlp_norm_w; const float* w_mlp_in; const float* w_mlp_out;
  float* out; unsigned char* ws; int ph_lo; int ph_hi;
};

DI unsigned cvt_pk_bf16(float lo, float hi) { unsigned r; asm("v_cvt_pk_bf16_f32 %0, %1, %2" : "=v"(r) : "v"(lo), "v"(hi)); return r; }
DI bf16_t f2bf(float x) { return (bf16_t)(cvt_pk_bf16(x, 0.f) & 0xffffu); }
DI float bf2f(bf16_t b) { return __uint_as_float(((unsigned)b) << 16); }
typedef _Float16 h16x2 __attribute__((ext_vector_type(2)));
DI unsigned pk_f16(float lo, float hi) { h16x2 v = {(_Float16)lo, (_Float16)hi}; return __builtin_bit_cast(unsigned, v); }
DI float f16lo(unsigned u) { return (float)__builtin_bit_cast(h16x2, u)[0]; }
DI float f16hi(unsigned u) { return (float)__builtin_bit_cast(h16x2, u)[1]; }
DI int opaque_tid() { int t = threadIdx.x; asm volatile("" : "+v"(t)); return t; }
DI float wave_sum(float v) {
#pragma unroll
  for (int o = 32; o > 0; o >>= 1) v += __shfl_xor(v, o);
  return v;
}
DI float wave_max(float v) {
#pragma unroll
  for (int o = 32; o > 0; o >>= 1) v = fmaxf(v, __shfl_xor(v, o));
  return v;
}
DI const float* xrow(const Params& p, int tok) { return tok < 32768 ? p.xp + (size_t)tok * 1024 : p.xs + (size_t)(tok - 32768) * 1024; }
DI void seqinfo(int tok, int& T0, int& S) {
  if (tok < 32768) { T0 = tok & ~8191; S = 8192; } else { T0 = 32768 + ((tok - 32768) & ~16383); S = 16384; }
}

DI void transpose_w(const float* __restrict__ W, int K, int N, bf16_t* __restrict__ Wt, int gtid, int gthreads) {
  const int total = (K / 8) * N;
  for (int id = gtid; id < total; id += gthreads) {
    const int kc = id / N, n = id - kc * N;
    const int rho = n & 255;
    const int act = (n & ~255) + ((rho >> 5) & 3) * 64 + (rho >> 7) * 32 + ((rho >> 2) & 3) * 8 + ((rho >> 4) & 1) * 4 + (rho & 3);
    const float* src = W + (size_t)(kc * 8) * N + act;
    float v[8];
#pragma unroll
    for (int j = 0; j < 8; ++j) v[j] = src[(size_t)j * N];
    uint4 o; o.x = cvt_pk_bf16(v[0], v[1]); o.y = cvt_pk_bf16(v[2], v[3]); o.z = cvt_pk_bf16(v[4], v[5]); o.w = cvt_pk_bf16(v[6], v[7]);
    *(uint4*)(Wt + (size_t)n * K + kc * 8) = o;
  }
}
DI void rms_row_bf16(const float* __restrict__ x, const float* __restrict__ w, bf16_t* __restrict__ o, int lane) {
  const float4* xr = (const float4*)x + lane; const float4* wr = (const float4*)w + lane;
  float4 v[4]; float s = 0.f;
#pragma unroll
  for (int j = 0; j < 4; ++j) { v[j] = xr[64 * j]; s += v[j].x * v[j].x + v[j].y * v[j].y + v[j].z * v[j].z + v[j].w * v[j].w; }
  s = wave_sum(s);
  const float rstd = rsqrtf(s * (1.f / 1024.f) + EPSN);
#pragma unroll
  for (int j = 0; j < 4; ++j) {
    const float4 ww = wr[64 * j];
    uint2 q; q.x = cvt_pk_bf16(v[j].x * rstd * ww.x, v[j].y * rstd * ww.y); q.y = cvt_pk_bf16(v[j].z * rstd * ww.z, v[j].w * rstd * ww.w);
    *(uint2*)(o + lane * 4 + 256 * j) = q;
  }
}
DI void rms_row2_bf16(const float* __restrict__ x, const float* __restrict__ w, bf16_t* __restrict__ o, int lane) {
  const float4* xr = (const float4*)x + lane; const float4* wr = (const float4*)w + lane;
  float4 v[2][4]; float s0 = 0.f, s1 = 0.f;
#pragma unroll
  for (int j = 0; j < 4; ++j) { v[0][j] = xr[64 * j]; v[1][j] = xr[256 + 64 * j]; }
#pragma unroll
  for (int j = 0; j < 4; ++j) {
    s0 += v[0][j].x * v[0][j].x + v[0][j].y * v[0][j].y + v[0][j].z * v[0][j].z + v[0][j].w * v[0][j].w;
    s1 += v[1][j].x * v[1][j].x + v[1][j].y * v[1][j].y + v[1][j].z * v[1][j].z + v[1][j].w * v[1][j].w;
  }
  s0 = wave_sum(s0); s1 = wave_sum(s1);
  const float r0 = rsqrtf(s0 * (1.f / 1024.f) + EPSN), r1 = rsqrtf(s1 * (1.f / 1024.f) + EPSN);
#pragma unroll
  for (int j = 0; j < 4; ++j) {
    const float4 ww = wr[64 * j];
    uint2 q; q.x = cvt_pk_bf16(v[0][j].x * r0 * ww.x, v[0][j].y * r0 * ww.y); q.y = cvt_pk_bf16(v[0][j].z * r0 * ww.z, v[0][j].w * r0 * ww.w);
    *(uint2*)(o + lane * 4 + 256 * j) = q;
    q.x = cvt_pk_bf16(v[1][j].x * r1 * ww.x, v[1][j].y * r1 * ww.y); q.y = cvt_pk_bf16(v[1][j].z * r1 * ww.z, v[1][j].w * r1 * ww.w);
    *(uint2*)(o + 1024 + lane * 4 + 256 * j) = q;
  }
}
DI void phase_prep(const Params& p) {
  const int tid = threadIdx.x, lane = tid & 63, wave = tid >> 6;
  if (blockIdx.x == 0 && tid == 0) *(unsigned*)(p.ws + WS_END) = 0u;
  { float* RS = (float*)(p.ws + WS_END + 8192); const int i = blockIdx.x * 512 + tid; if (i < NTOK) RS[i] = 0.f; }
  if (blockIdx.x == 1) {
    float* LB = (float*)(p.ws + WS_END + 256);
    for (int i = tid; i < 1024; i += 512) { const int dir = i >> 9, ch = i & 511; LB[i] = 1.f / (1.f + expf(p.hgrn_lb[(dir * 2 + 1) * 512 + ch] - p.hgrn_lb[(dir * 2 + 0) * 512 + ch])); }
  }
  const int gthreads = gridDim.x * 512, gtid = blockIdx.x * 512 + tid;
  transpose_w(p.w_in, 1024, 4096, (bf16_t*)(p.ws + WS_WIN), gtid, gthreads);
  transpose_w(p.w_out, 1024, 1024, (bf16_t*)(p.ws + WS_WOUT), gtid, gthreads);
  transpose_w(p.w_mlp_in, 1024, 4096, (bf16_t*)(p.ws + WS_WM1), gtid, gthreads);
  transpose_w(p.w_mlp_out, 4096, 1024, (bf16_t*)(p.ws + WS_WM2), gtid, gthreads);
  bf16_t* H = (bf16_t*)(p.ws + WS_H);
  for (int tok = (blockIdx.x * 8 + wave) * 2; tok < NTOK; tok += gridDim.x * 16) rms_row2_bf16(xrow(p, tok), p.attn_norm_w, H + (size_t)tok * 1024, lane);
}
DI void phase_norm2(const Params& p) {
  const int tid = threadIdx.x, lane = tid & 63, wave = tid >> 6;
  bf16_t* H = (bf16_t*)(p.ws + WS_H);
  for (int tok = blockIdx.x * 8 + wave; tok < NTOK; tok += gridDim.x * 8) rms_row_bf16(p.out + (size_t)tok * 1024, p.mlp_norm_w, H + (size_t)tok * 1024, lane);
}

#define LAS __attribute__((address_space(3)))
constexpr int BM = 256, BK = 64, HALF = 128, HTB = HALF * BK * 2;
DI int lds_byte(int r, int c) {
  int st = (r >> 4) * 2 + (c >> 5), rr = r & 15, cc = c & 31, ob = rr * 64 + cc * 2;
  return st * 1024 + (ob ^ (((ob >> 9) & 1) << 5));
}
DI void stage_rc(int b, int& R, int& C) {
  int st = b / 1024, sb = b % 1024, swz = sb ^ (((sb >> 9) & 1) << 5);
  R = (st >> 1) * 16 + swz / 64; C = (st & 1) * 32 + (swz % 64) / 2;
}
DI int pi256(int rho) { return ((rho >> 5) & 3) * 64 + (rho >> 7) * 32 + ((rho >> 2) & 3) * 8 + ((rho >> 4) & 1) * 4 + (rho & 3); }

template <int EPI>
DI void gemm_epilogue(f32x4 (&acc)[2][2][4][2], const int pm, const int pn, const int wr, const int wc, const int fr, const int fq, const Params& p) {
  if constexpr (EPI == 0) {
    int T0, S; seqinfo(pm * 256, T0, S);
    const int typ = pn >> 1, gi = (pn & 1) * 4 + wc;
    unsigned char* ws = p.ws;
    if (typ < 2) {
      const float* nw = p.qk_norm_w + typ * 64;
      const float mul = typ ? 1.f : 0.125f * LOG2E;
      float wv[2][8];
#pragma unroll
      for (int bj = 0; bj < 2; ++bj)
#pragma unroll
        for (int j = 0; j < 8; ++j) wv[bj][j] = nw[bj * 32 + fq * 8 + j] * mul;
      bf16_t* dst = (bf16_t*)(ws + (typ ? WS_KA : WS_QA)) + (size_t)T0 * 512 + (size_t)gi * S * 64;
#pragma unroll
      for (int ai = 0; ai < 2; ++ai)
#pragma unroll
        for (int m = 0; m < 4; ++m) {
          float ss = 0.f;
#pragma unroll
          for (int bj = 0; bj < 2; ++bj)
#pragma unroll
            for (int n = 0; n < 2; ++n)
#pragma unroll
              for (int e = 0; e < 4; ++e) { const float a = acc[ai][bj][m][n][e]; ss += a * a; }
          ss += __shfl_xor(ss, 16); ss += __shfl_xor(ss, 32);
          const float rstd = rsqrtf(ss * (1.f / 64.f) + EPSN);
          const int s = pm * 256 + ai * 128 + wr * 64 + m * 16 + fr - T0;
#pragma unroll
          for (int bj = 0; bj < 2; ++bj) {
            uint4 q;
            q.x = cvt_pk_bf16(acc[ai][bj][m][0][0] * rstd * wv[bj][0], acc[ai][bj][m][0][1] * rstd * wv[bj][1]);
            q.y = cvt_pk_bf16(acc[ai][bj][m][0][2] * rstd * wv[bj][2], acc[ai][bj][m][0][3] * rstd * wv[bj][3]);
            q.z = cvt_pk_bf16(acc[ai][bj][m][1][0] * rstd * wv[bj][4], acc[ai][bj][m][1][1] * rstd * wv[bj][5]);
            q.w = cvt_pk_bf16(acc[ai][bj][m][1][2] * rstd * wv[bj][6], acc[ai][bj][m][1][3] * rstd * wv[bj][7]);
            *(uint4*)(dst + (size_t)s * 64 + bj * 32 + fq * 8) = q;
          }
        }
    } else if (typ == 2 || typ == 6) {
      bf16_t* dst = (bf16_t*)(ws + (typ == 2 ? WS_VAT : WS_IHT)) + (size_t)T0 * 512 + (size_t)((pn & 1) * 256) * S;
      const int tbase = pm * 256 - T0 + wc * 32 + fq * 4;
#pragma unroll
      for (int ai = 0; ai < 2; ++ai)
#pragma unroll
        for (int m = 0; m < 4; ++m) {
          const int d = pi256(ai * 128 + wr * 64 + m * 16 + fr);
#pragma unroll
          for (int bj = 0; bj < 2; ++bj)
#pragma unroll
            for (int n = 0; n < 2; ++n) {
              const f32x4 a = acc[ai][bj][m][n];
              uint2 q; q.x = cvt_pk_bf16(a[0], a[1]); q.y = cvt_pk_bf16(a[2], a[3]);
              *(uint2*)(dst + (size_t)d * S + tbase + bj * 128 + n * 16) = q;
            }
        }
    } else {
      const size_t off = typ == 3 ? WS_QH : typ == 4 ? WS_FFW : typ == 5 ? WS_FBW : WS_GH;
      bf16_t* dst = (bf16_t*)(ws + off);
      const float mul = typ == 3 ? 0.08838834764831845f : 1.f;
      const bool act = (typ == 3 || typ == 7);
      if (typ == 4 || typ == 5) {
        const float* LB = (const float*)(ws + WS_END + 256) + (typ - 4) * 512 + gi * 64 + fq * 8;
        float lbv[2][8];
#pragma unroll
        for (int bj = 0; bj < 2; ++bj)
#pragma unroll
          for (int j = 0; j < 8; ++j) lbv[bj][j] = LB[bj * 32 + j];
#pragma unroll
        for (int ai = 0; ai < 2; ++ai)
#pragma unroll
          for (int m = 0; m < 4; ++m) {
            const int row = pm * 256 + ai * 128 + wr * 64 + m * 16 + fr;
#pragma unroll
            for (int bj = 0; bj < 2; ++bj) {
              float v[8];
#pragma unroll
              for (int n = 0; n < 2; ++n)
#pragma unroll
                for (int e = 0; e < 4; ++e) {
                  const float a = acc[ai][bj][m][n][e], lb = lbv[bj][n * 4 + e];
                  const float sg = __builtin_amdgcn_rcpf(1.f + __expf(-a));
                  v[n * 4 + e] = __logf(lb + (1.f - lb) * sg);
                }
              uint4 q; q.x = pk_f16(v[0], v[1]); q.y = pk_f16(v[2], v[3]); q.z = pk_f16(v[4], v[5]); q.w = pk_f16(v[6], v[7]);
              *(uint4*)(dst + (size_t)row * 512 + gi * 64 + bj * 32 + fq * 8) = q;
            }
          }
      } else
#pragma unroll
      for (int ai = 0; ai < 2; ++ai)
#pragma unroll
        for (int m = 0; m < 4; ++m) {
          const int row = pm * 256 + ai * 128 + wr * 64 + m * 16 + fr;
#pragma unroll
          for (int bj = 0; bj < 2; ++bj) {
            float v[8];
#pragma unroll
            for (int n = 0; n < 2; ++n)
#pragma unroll
              for (int e = 0; e < 4; ++e) { float a = acc[ai][bj][m][n][e]; if (act) a = a * mul * __builtin_amdgcn_rcpf(1.f + __expf(-a)); v[n * 4 + e] = a; }
            uint4 q; q.x = cvt_pk_bf16(v[0], v[1]); q.y = cvt_pk_bf16(v[2], v[3]); q.z = cvt_pk_bf16(v[4], v[5]); q.w = cvt_pk_bf16(v[6], v[7]);
            *(uint4*)(dst + (size_t)row * 512 + gi * 64 + bj * 32 + fq * 8) = q;
          }
        }
    }
  } else if constexpr (EPI == 1) {
    const int col = pn * 256 + wc * 64 + fq * 8;
    float wv[2][8];
#pragma unroll
    for (int bj = 0; bj < 2; ++bj)
#pragma unroll
      for (int j = 0; j < 8; ++j) wv[bj][j] = p.mlp_norm_w[col + bj * 32 + j];
    bf16_t* H = (bf16_t*)(p.ws + WS_H);
    float* RS = (float*)(p.ws + WS_END + 8192);
#pragma unroll
    for (int ai = 0; ai < 2; ++ai)
#pragma unroll
      for (int m = 0; m < 4; ++m) {
        const int row = pm * 256 + ai * 128 + wr * 64 + m * 16 + fr;
        const float* xr = xrow(p, row) + col;
        float* orow = p.out + (size_t)row * 1024 + col;
        float ss = 0.f;
#pragma unroll
        for (int bj = 0; bj < 2; ++bj) {
          float v[8];
#pragma unroll
          for (int n = 0; n < 2; ++n) {
            const float4 x = *(const float4*)(xr + bj * 32 + n * 4);
            const f32x4 a = acc[ai][bj][m][n];
            float4 o; o.x = x.x + a[0]; o.y = x.y + a[1]; o.z = x.z + a[2]; o.w = x.w + a[3];
            *(float4*)(orow + bj * 32 + n * 4) = o;
            ss += o.x * o.x + o.y * o.y + o.z * o.z + o.w * o.w;
            v[n * 4 + 0] = o.x * wv[bj][n * 4 + 0]; v[n * 4 + 1] = o.y * wv[bj][n * 4 + 1]; v[n * 4 + 2] = o.z * wv[bj][n * 4 + 2]; v[n * 4 + 3] = o.w * wv[bj][n * 4 + 3];
          }
          uint4 q; q.x = cvt_pk_bf16(v[0], v[1]); q.y = cvt_pk_bf16(v[2], v[3]); q.z = cvt_pk_bf16(v[4], v[5]); q.w = cvt_pk_bf16(v[6], v[7]);
          *(uint4*)(H + (size_t)row * 1024 + col + bj * 32) = q;
        }
        ss += __shfl_xor(ss, 16); ss += __shfl_xor(ss, 32);
        if (fq == 0) unsafeAtomicAdd(RS + row, ss);
      }
  } else if constexpr (EPI == 3) {
#pragma unroll
    for (int ai = 0; ai < 2; ++ai)
#pragma unroll
      for (int m = 0; m < 4; ++m) {
        const int row = pm * 256 + ai * 128 + wr * 64 + m * 16 + fr;
        const int col = pn * 256 + wc * 64 + fq * 8;
        const float* xr = p.out + (size_t)row * 1024 + col;
        float* orow = p.out + (size_t)row * 1024 + col;
#pragma unroll
        for (int bj = 0; bj < 2; ++bj)
#pragma unroll
          for (int n = 0; n < 2; ++n) {
            const float4 x = *(const float4*)(xr + bj * 32 + n * 4);
            const f32x4 a = acc[ai][bj][m][n];
            float4 o; o.x = x.x + a[0]; o.y = x.y + a[1]; o.z = x.z + a[2]; o.w = x.w + a[3];
            *(float4*)(orow + bj * 32 + n * 4) = o;
          }
      }
  } else {
    bf16_t* hid = (bf16_t*)(p.ws + WS_BIG);
#pragma unroll
    for (int ai = 0; ai < 2; ++ai)
#pragma unroll
      for (int m = 0; m < 4; ++m) {
        const int row = pm * 256 + ai * 128 + wr * 64 + m * 16 + fr;
        const float r2 = __builtin_amdgcn_rcpf(((const float*)(p.ws + WS_END + 8192))[row] * (1.f / 1024.f) + EPSN);
#pragma unroll
        for (int bj = 0; bj < 2; ++bj) {
          float v[8];
#pragma unroll
          for (int n = 0; n < 2; ++n)
#pragma unroll
            for (int e = 0; e < 4; ++e) { const float a = fmaxf(acc[ai][bj][m][n][e], 0.f); v[n * 4 + e] = a * a * r2; }
          uint4 q; q.x = cvt_pk_bf16(v[0], v[1]); q.y = cvt_pk_bf16(v[2], v[3]); q.z = cvt_pk_bf16(v[4], v[5]); q.w = cvt_pk_bf16(v[6], v[7]);
          *(uint4*)(hid + (size_t)row * 4096 + pn * 256 + wc * 64 + bj * 32 + fq * 8) = q;
        }
      }
  }
}

template <int EPI>
DI void phase_gemm(const Params& p, const bf16_t* Ag, const bf16_t* Btg, const int N, const int K) {
  extern __shared__ __attribute__((aligned(16))) char shm_raw[];
  LAS unsigned char* lds = (LAS unsigned char*)shm_raw;
  const int tid = opaque_tid(), wid = __builtin_amdgcn_readfirstlane(tid >> 6), lane = tid & 63, wr = wid >> 2, wc = wid & 3, fr = lane & 15, fq = lane >> 4;
  const int nt = K / BK, nN = N / 256, nunits = 256 * nN, G = gridDim.x;
  unsigned voff[2];
#pragma unroll
  for (int i = 0; i < 2; ++i) { int R, C; stage_rc(tid * 16 + i * 8192, R, C); voff[i] = (unsigned)(R * K + C) * 2u; }
  const size_t kstep = (size_t)(BK * 2);
  const size_t hstep = (size_t)HALF * K * 2;
  const size_t tstep = 2 * hstep;
  const unsigned ldsw = (unsigned)wid * 1024u;
  const int aoff = lds_byte(wr * 64 + fr, fq * 8), boff = lds_byte(wc * 32 + fr, fq * 8);
#define PG8_SA(b, h) (((b) * 2 + (h)) * HTB)
#define PG8_SB(b, h) ((4 + (b) * 2 + (h)) * HTB)
  const __amdgpu_buffer_rsrc_t grs = __builtin_amdgcn_make_buffer_rsrc((void*)p.ws, 0, 0xFFFFFFF0u, 0x00020000);
#define PG8_STAGE(bufoff, gbase) do { const int _so = (int)((const char*)(gbase) - (const char*)p.ws); _Pragma("unroll") for (int _i = 0; _i < 2; ++_i) \
    __builtin_amdgcn_raw_ptr_buffer_load_lds(grs, (LAS void*)(lds + (bufoff) + ldsw + _i * 8192), 16, (int)voff[_i], _so, 0, 0); } while (0)
#define PG8_LDA(dst, b, h) do { _Pragma("unroll") for (int m = 0; m < 4; ++m) _Pragma("unroll") for (int k = 0; k < 2; ++k) dst[m][k] = *(const LAS bf16x8*)(lds + PG8_SA(b, h) + aoff + m * 2048 + k * 1024); } while (0)
#define PG8_LDB(dst, b, h) do { _Pragma("unroll") for (int n = 0; n < 2; ++n) _Pragma("unroll") for (int k = 0; k < 2; ++k) dst[n][k] = *(const LAS bf16x8*)(lds + PG8_SB(b, h) + boff + n * 2048 + k * 1024); } while (0)
#define PG8_MMA(ai, bj, At, Bq) do { __builtin_amdgcn_s_setprio(1); _Pragma("unroll") for (int m = 0; m < 4; ++m) _Pragma("unroll") for (int n = 0; n < 2; ++n) _Pragma("unroll") for (int k = 0; k < 2; ++k) \
    acc[ai][bj][m][n] = __builtin_amdgcn_mfma_f32_16x16x32_bf16(Bq[n][k], At[m][k], acc[ai][bj][m][n], 0, 0, 0); __builtin_amdgcn_s_setprio(0); } while (0)
#define PG8_WAIT_V(n) asm volatile("s_waitcnt vmcnt(" #n ")" ::: "memory")
#define PG8_WAIT_L(n) asm volatile("s_waitcnt lgkmcnt(" #n ")" ::: "memory")
#define PG8_BAR __builtin_amdgcn_s_barrier()
#define PG8_SCHED __builtin_amdgcn_sched_barrier(0)
  const int xcd = blockIdx.x & 7, jloc = blockIdx.x >> 3, CP = nN < 8 ? nN : 8, RP = 32 / CP, cblocks = nN / CP;
  const int jr = jloc / CP, jc = jloc - jr * CP;
#define UNIT_PTRS(u, pmv, pnv, pa, pb) do { const int _i = (u) >> 8, _br = _i / cblocks, _bc = _i - _br * cblocks; \
    pmv = 32 * xcd + _br * RP + jr; pnv = _bc * CP + jc; \
    const char* _ha = (const char*)Ag + (size_t)pmv * tstep; const char* _wb = (const char*)Btg + (size_t)pnv * tstep; \
    const bool _sw = (EPI == 0) && (((pnv >> 1) & 3) == 2); pa = _sw ? _wb : _ha; pb = _sw ? _ha : _wb; } while (0)
  int ui = 0;
  int u = blockIdx.x;
  if (u >= nunits) return;
  int pm, pn; const char* cA; const char* cB;
  UNIT_PTRS(u, pm, pn, cA, cB);
  f32x4 acc[2][2][4][2];
#pragma unroll
  for (int a = 0; a < 2; ++a)
#pragma unroll
    for (int b = 0; b < 2; ++b)
#pragma unroll
      for (int m = 0; m < 4; ++m)
#pragma unroll
        for (int n = 0; n < 2; ++n) acc[a][b][m][n] = (f32x4){0.f, 0.f, 0.f, 0.f};
  bf16x8 At[4][2], B0[2][2], B1[2][2];
  PG8_STAGE(PG8_SB(0, 0), cB); PG8_STAGE(PG8_SA(0, 0), cA); PG8_STAGE(PG8_SB(0, 1), cB + hstep); PG8_STAGE(PG8_SA(0, 1), cA + hstep);
  if (wr == 1) PG8_BAR;
  PG8_WAIT_V(4); PG8_BAR;
  PG8_STAGE(PG8_SB(1, 0), cB + kstep); PG8_STAGE(PG8_SA(1, 0), cA + kstep); PG8_STAGE(PG8_SB(1, 1), cB + hstep + kstep);
  PG8_WAIT_V(6); PG8_BAR;
  for (;;) {
    const int un = u + G;
    const bool has_next = un < nunits;
    int pm2 = pm, pn2 = pn; const char* nA = cA; const char* nB = cB;
    if (has_next) { UNIT_PTRS(un, pm2, pn2, nA, nB); }
    for (int t = 0; t < nt; t += 2) {
      const bool last = (t == nt - 2);
      const char* a1 = cA + (size_t)(t + 1) * kstep;
      const char* a2 = last ? nA : cA + (size_t)(t + 2) * kstep; const char* b2 = last ? nB : cB + (size_t)(t + 2) * kstep;
      const char* a3 = a2 + kstep; const char* b3 = b2 + kstep;
      PG8_LDB(B0, 0, 0); PG8_SCHED; PG8_LDA(At, 0, 0); PG8_STAGE(PG8_SA(1, 1), a1 + hstep);
      PG8_WAIT_L(8); PG8_BAR; PG8_WAIT_L(0); PG8_MMA(0, 0, At, B0); PG8_BAR; PG8_SCHED;
      PG8_LDB(B1, 0, 1); PG8_STAGE(PG8_SB(0, 0), b2);
      PG8_BAR; PG8_WAIT_L(0); PG8_MMA(0, 1, At, B1); PG8_BAR;
      PG8_LDA(At, 0, 1); PG8_STAGE(PG8_SA(0, 0), a2);
      PG8_BAR; PG8_WAIT_L(0); PG8_MMA(1, 0, At, B0); PG8_BAR; PG8_SCHED;
      PG8_STAGE(PG8_SB(0, 1), b2 + hstep);
      PG8_WAIT_V(6); PG8_BAR; PG8_MMA(1, 1, At, B1); PG8_BAR;
      PG8_LDB(B0, 1, 0); PG8_SCHED; PG8_LDA(At, 1, 0); PG8_STAGE(PG8_SA(0, 1), a2 + hstep);
      PG8_WAIT_L(8); PG8_BAR; PG8_WAIT_L(0); PG8_MMA(0, 0, At, B0); PG8_BAR; PG8_SCHED;
      PG8_LDB(B1, 1, 1); PG8_STAGE(PG8_SB(1, 0), b3);
      PG8_BAR; PG8_WAIT_L(0); PG8_MMA(0, 1, At, B1); PG8_BAR;
      PG8_LDA(At, 1, 1); PG8_STAGE(PG8_SA(1, 0), a3);
      PG8_BAR; PG8_WAIT_L(0); PG8_MMA(1, 0, At, B0); PG8_BAR; PG8_SCHED;
      PG8_STAGE(PG8_SB(1, 1), b3 + hstep);
      PG8_WAIT_V(6); PG8_BAR; PG8_MMA(1, 1, At, B1); PG8_BAR;
    }
    gemm_epilogue<EPI>(acc, pm, pn, wr, wc, fr, fq, p);
    if (!has_next) break;
#pragma unroll
    for (int a = 0; a < 2; ++a)
#pragma unroll
      for (int b = 0; b < 2; ++b)
#pragma unroll
        for (int m = 0; m < 4; ++m)
#pragma unroll
          for (int n = 0; n < 2; ++n) acc[a][b][m][n] = (f32x4){0.f, 0.f, 0.f, 0.f};
    u = un; pm = pm2; pn = pn2; cA = nA; cB = nB; ++ui;
  }
  PG8_WAIT_V(0);
  if (wr == 0) PG8_BAR;
  PG8_BAR;
#undef PG8_SA
#undef PG8_SB
#undef PG8_STAGE
#undef PG8_LDA
#undef PG8_LDB
#undef PG8_MMA
#undef UNIT_PTRS
}

DI int t5_bucket(int rel) {
  const int n = rel < 0 ? -rel : rel;
  int b;
  if (n < 8) b = n;
  else { int lg = 8 + (int)(logf((float)n / 8.f) / 2.772588722239781f * 8.f); b = lg < 15 ? lg : 15; }
  return (rel > 0 ? 16 : 0) + b;
}

DI void mixer_consts(const Params& p, float* sC) {
  if (threadIdx.x < 64) {
    const int l = threadIdx.x;
    const float wq = wave_max(fabsf(p.qk_norm_w[l])), wk = wave_max(fabsf(p.qk_norm_w[64 + l]));
    const float d1 = wave_sum(p.diff_lambda[l] * p.diff_lambda[64 + l]), d2 = wave_sum(p.diff_lambda[128 + l] * p.diff_lambda[192 + l]);
    if (l == 0) { sC[0] = expf(d1) - expf(d2) + 0.2f; sC[1] = 8.f * wq * wk * 1.01f; }
  }
  __syncthreads();
}

using f32x16 = __attribute__((ext_vector_type(16))) float;
typedef float f32x2 __attribute__((ext_vector_type(2)));
typedef __bf16 bf16x2_t __attribute__((ext_vector_type(2)));
typedef unsigned u32x4 __attribute__((ext_vector_type(4)));
DI unsigned pk_bf16(float lo, float hi) { f32x2 v = {lo, hi}; return __builtin_bit_cast(unsigned, __builtin_convertvector(v, bf16x2_t)); }
#define MFMA32(a, b, c) __builtin_amdgcn_mfma_f32_32x32x16_bf16((a), (b), (c), 0, 0, 0)

DI void attn_item(const Params& p, const int item) {
  extern __shared__ __attribute__((aligned(16))) char shm_raw[];
  LAS unsigned char* lds = (LAS unsigned char*)shm_raw;
  int h, qb, S, T0;
  if (item < 1024) { h = (item >> 7) & 3; qb = item & 127; S = 16384; T0 = 32768 + (item >> 9) * 16384; }
  else { const int it = item - 1024; h = (it >> 6) & 3; qb = it & 63; S = 8192; T0 = (it >> 8) * 8192; }
  const int tid = opaque_tid(), wid = __builtin_amdgcn_readfirstlane(tid >> 6), lane = tid & 63, r = lane & 31, hl = lane >> 5;
  const int qs = wid & 3, c = wid >> 2;
  float* sTab = (float*)(shm_raw + 131072);
  float* sC = sTab + 320;
  __syncthreads();
  mixer_consts(p, sC);
  const float lam = sC[0];
  float maxb = -1e30f;
  for (int b = 0; b < 32; ++b) maxb = fmaxf(maxb, p.rel_bias[b * 4 + h]);
  const float Mshift = sC[1] + maxb;
  if (tid < 257) sTab[tid] = (p.rel_bias[t5_bucket(tid - 128) * 4 + h] - Mshift) * LOG2E;
  const float cL = (p.rel_bias[15 * 4 + h] - Mshift) * LOG2E, cR = (p.rel_bias[31 * 4 + h] - Mshift) * LOG2E;

  const int q0 = qb * 128, qpos = q0 + qs * 32 + r;
  const bf16_t* QAp = (const bf16_t*)(p.ws + WS_QA) + (size_t)T0 * 512 + (size_t)((h * 2 + c) * S) * 64;
  bf16x8 Qf[4];
#pragma unroll
  for (int ks = 0; ks < 4; ++ks) Qf[ks] = *(const bf16x8*)(QAp + (size_t)qpos * 64 + ks * 16 + hl * 8);

  const int j0 = (wid & 3) * 4;
  const char* sbase; unsigned soff[2]; size_t cstride, inc;
  if (wid < 4) {
    const int cc = j0 >> 3;
    sbase = (const char*)((const bf16_t*)(p.ws + WS_KA) + (size_t)T0 * 512 + (size_t)((h * 2 + cc) * S) * 64) + (size_t)(8 * (j0 & 7)) * 128;
    cstride = 1024; inc = 8192;
#pragma unroll
    for (int e = 0; e < 2; ++e) { const int R = 8 * ((j0 & 7) + e) + (lane >> 3), g = (lane & 7) ^ ((R >> 1) & 7); soff[e] = (unsigned)((lane >> 3) * 128 + g * 16); }
  } else {
    sbase = (const char*)((const bf16_t*)(p.ws + WS_VAT) + (size_t)T0 * 512 + (size_t)(h * 128 + 8 * j0) * S);
    cstride = (size_t)16 * S; inc = 128;
#pragma unroll
    for (int e = 0; e < 2; ++e) { const int R = 8 * (j0 + e) + (lane >> 3), g = (lane & 7) ^ ((R >> 1) & 7); soff[e] = (unsigned)((lane >> 3) * S * 2 + g * 16); }
  }
  const int stg_base = (wid < 4 ? 0 : 49152) + (wid & 3) * 4096;
  const __amdgpu_buffer_rsrc_t srs = __builtin_amdgcn_make_buffer_rsrc((void*)sbase, 0, 0x40000000, 0x00020000);
#define ATT_STAGE(t, ring) do { const int _so = (int)((size_t)(t) * inc); _Pragma("unroll") for (int _i = 0; _i < 4; ++_i) \
    __builtin_amdgcn_raw_ptr_buffer_load_lds(srs, (LAS void*)(lds + stg_base + (ring) * 16384 + _i * 1024), 16, (int)soff[_i & 1], _so + (int)(_i * cstride), 0, 0); } while (0)

  const int kap = (r & 19) | ((r & 4) << 1) | ((r & 8) >> 1);
  const int swk = (kap >> 1) & 7, swv = (r >> 1) & 7;
  int koff[4], voff[4];
#pragma unroll
  for (int s = 0; s < 4; ++s) { koff[s] = c * 8192 + kap * 128 + (((2 * s + hl) ^ swk) << 4); voff[s] = 49152 + r * 128 + (((2 * s + hl) ^ swv) << 4); }

  f32x16 O[4];
#pragma unroll
  for (int db = 0; db < 4; ++db)
#pragma unroll
    for (int i = 0; i < 16; ++i) O[db][i] = 0.f;
  const int tL = q0 >= 192 ? (q0 - 128) >> 6 : 0, tR = (q0 + 256) >> 6;
  const float fL = __builtin_amdgcn_exp2f(cL), fR = __builtin_amdgcn_exp2f(-cR);
  const f32x16 Zf = {0.f, 0.f, 0.f, 0.f, 0.f, 0.f, 0.f, 0.f, 0.f, 0.f, 0.f, 0.f, 0.f, 0.f, 0.f, 0.f};
  float lsum = 0.f;
  const int nT = S >> 6;
  bf16x8 kf[2][4];
  f32x16 X[2];
  bf16x8 pf[4];
#define ATT_LDK(ring) do { _Pragma("unroll") for (int kh = 0; kh < 2; ++kh) _Pragma("unroll") for (int ks = 0; ks < 4; ++ks) \
    kf[kh][ks] = *(const LAS bf16x8*)(lds + (ring) * 16384 + kh * 4096 + koff[ks]); } while (0)
#define ATT_QK(tt) do { const int k0 = (tt) << 6; \
    const bool far = ((tt) < tL) || ((tt) >= tR); \
    if ((tt) == tL && tL > 0) lsum *= fL; \
    if ((tt) == tR) lsum *= fR; \
    if (far) { _Pragma("unroll") for (int kh = 0; kh < 2; ++kh) X[kh] = MFMA32(kf[kh][0], Qf[0], Zf); } \
    else { _Pragma("unroll") for (int kh = 0; kh < 2; ++kh) { f32x16 bi; \
        _Pragma("unroll") for (int i = 0; i < 16; ++i) { \
          const int key = k0 + 32 * kh + (i & 3) + 4 * ((i >> 2) & 1) + 8 * hl + 16 * (i >> 3); \
          int rel = key - qpos; rel = rel < -128 ? -128 : (rel > 128 ? 128 : rel); bi[i] = sTab[rel + 128]; } \
        X[kh] = MFMA32(kf[kh][0], Qf[0], bi); } } \
    _Pragma("unroll") for (int ks = 1; ks < 4; ++ks) _Pragma("unroll") for (int kh = 0; kh < 2; ++kh) X[kh] = MFMA32(kf[kh][ks], Qf[ks], X[kh]); } while (0)
#define ATT_SM(kh, dst) do { _Pragma("unroll") for (int i = 0; i < 16; ++i) { X[kh][i] = __builtin_amdgcn_exp2f(X[kh][i]); lsum += X[kh][i]; } \
    _Pragma("unroll") for (int s2 = 0; s2 < 2; ++s2) { u32x4 pk; \
      pk[0] = pk_bf16(X[kh][8 * s2 + 0], X[kh][8 * s2 + 1]); pk[1] = pk_bf16(X[kh][8 * s2 + 2], X[kh][8 * s2 + 3]); \
      pk[2] = pk_bf16(X[kh][8 * s2 + 4], X[kh][8 * s2 + 5]); pk[3] = pk_bf16(X[kh][8 * s2 + 6], X[kh][8 * s2 + 7]); \
      dst[2 * (kh) + s2] = __builtin_bit_cast(bf16x8, pk); } } while (0)

  ATT_STAGE(0, 0); ATT_STAGE(1, 1);
  if (wid < 4) { ATT_STAGE(2, 2); PG8_WAIT_V(8); }
  PG8_BAR;
  ATT_LDK(0);
  ATT_QK(0);
  PG8_WAIT_L(0); PG8_BAR;
  if (wid < 4) ATT_STAGE(3, 0);
  ATT_SM(0, pf); ATT_SM(1, pf);
  if (wid < 4) PG8_WAIT_V(8);
  PG8_BAR;
  ATT_LDK(1);
  int m0 = 0, m1 = 1, m2 = 2;
  for (int t = 0; t < nT - 1; ++t) {
    PG8_WAIT_L(0); PG8_WAIT_V(4); PG8_BAR;
    { const int tk = t + 4 < nT ? t + 4 : nT - 1, tv = t + 2 < nT ? t + 2 : nT - 1; if (wid < 4) ATT_STAGE(tk, m1); else ATT_STAGE(tv, m2); }
    const LAS unsigned char* vb = lds + m0 * 16384;
    if ((t == tL && tL > 0) || t == tR) {
      const float f = t == tR ? fR : fL;
#pragma unroll
      for (int db = 0; db < 4; ++db)
#pragma unroll
        for (int i = 0; i < 16; ++i) O[db][i] *= f;
    }
    bf16x8 vfA[4][2], vfB[4][2];
#pragma unroll
    for (int db = 0; db < 4; ++db)
#pragma unroll
      for (int s = 0; s < 2; ++s) vfA[db][s] = *(const LAS bf16x8*)(vb + db * 4096 + voff[s]);
    ATT_QK(t + 1);
    PG8_SCHED;
#pragma unroll
    for (int db = 0; db < 4; ++db)
#pragma unroll
      for (int s = 0; s < 2; ++s) vfB[db][s] = *(const LAS bf16x8*)(vb + db * 4096 + voff[s + 2]);
    bf16x8 pfN[4];
#pragma unroll
    for (int s = 0; s < 2; ++s)
#pragma unroll
      for (int db = 0; db < 4; ++db) O[db] = MFMA32(vfA[db][s], pf[s], O[db]);
    ATT_SM(0, pfN);
    PG8_SCHED;
    ATT_LDK(m2);
#pragma unroll
    for (int s = 0; s < 2; ++s)
#pragma unroll
      for (int db = 0; db < 4; ++db) O[db] = MFMA32(vfB[db][s], pf[s + 2], O[db]);
    ATT_SM(1, pfN);
    PG8_SCHED;
#pragma unroll
    for (int s = 0; s < 4; ++s) pf[s] = pfN[s];
    { const int mm = m0; m0 = m1; m1 = m2; m2 = mm; }
  }
  PG8_WAIT_V(0); PG8_BAR;
  {
    const LAS unsigned char* vb = lds + m0 * 16384;
    if ((nT - 1 == tL && tL > 0) || nT - 1 == tR) {
      const float f = nT - 1 == tR ? fR : fL;
#pragma unroll
      for (int db = 0; db < 4; ++db)
#pragma unroll
        for (int i = 0; i < 16; ++i) O[db][i] *= f;
    }
#pragma unroll
    for (int db = 0; db < 4; ++db)
#pragma unroll
      for (int s = 0; s < 4; ++s) { const bf16x8 vf = *(const LAS bf16x8*)(vb + db * 4096 + voff[s]); O[db] = MFMA32(vf, pf[s], O[db]); }
  }
#undef ATT_LDK
#undef ATT_QK
#undef ATT_SM
  PG8_WAIT_V(0); PG8_BAR;
  lsum += __shfl_xor(lsum, 32);
  const float sc = (c ? lam : 1.f) / lsum;
  float* ex = (float*)shm_raw;
  if (c == 1) {
#pragma unroll
    for (int db = 0; db < 4; ++db)
#pragma unroll
      for (int i = 0; i < 16; ++i) ex[(qs * 128 + 32 * db + (i & 3) + 8 * (i >> 2) + 4 * hl) * 32 + r] = O[db][i] * sc;
  }
  __syncthreads();
  if (c == 0) {
    float ss = 0.f;
#pragma unroll
    for (int db = 0; db < 4; ++db)
#pragma unroll
      for (int i = 0; i < 16; ++i) { const float o = O[db][i] * sc - ex[(qs * 128 + 32 * db + (i & 3) + 8 * (i >> 2) + 4 * hl) * 32 + r]; O[db][i] = o; ss += o * o; }
    ss += __shfl_xor(ss, 32);
    const float rstd = rsqrtf(ss * (1.f / 128.f) + EPSN) * 0.8f;
    bf16_t* dst = (bf16_t*)(p.ws + WS_OCAT) + (size_t)(T0 + qpos) * 1024 + h * 128;
#pragma unroll
    for (int db = 0; db < 4; ++db)
#pragma unroll
      for (int i4 = 0; i4 < 4; ++i4) {
        const int d0 = 32 * db + 8 * i4 + 4 * hl;
        const float4 w = *(const float4*)(p.diff_subln_w + d0);
        uint2 q; q.x = pk_bf16(O[db][4 * i4] * rstd * w.x, O[db][4 * i4 + 1] * rstd * w.y); q.y = pk_bf16(O[db][4 * i4 + 2] * rstd * w.z, O[db][4 * i4 + 3] * rstd * w.w);
        *(uint2*)(dst + d0) = q;
      }
  }
#undef ATT_STAGE
}

#define MFMA16(a, b, c) __builtin_amdgcn_mfma_f32_16x16x32_bf16((a), (b), (c), 0, 0, 0)
typedef short s16x4 __attribute__((ext_vector_type(4)));
constexpr int HG_QT = 0, HG_KT = 17408, HG_KST = 34816, HG_AM = 53248, HG_DEC = 62464, HG_SEG = 62976, HG_VT = 67584;

DI void hgrn_item(const Params& p, const int ch) {
  extern __shared__ __attribute__((aligned(16))) char shm_raw[];
  LAS unsigned char* lds = (LAS unsigned char*)shm_raw;
  int hh, dir, S, T0;
  if (ch < 16) { hh = (ch >> 1) & 3; dir = ch & 1; S = 16384; T0 = 32768 + (ch >> 3) * 16384; }
  else { const int cc = ch - 16; hh = (cc >> 1) & 3; dir = cc & 1; S = 8192; T0 = (cc >> 3) * 8192; }
  const int tid = opaque_tid(), wid = __builtin_amdgcn_readfirstlane(tid >> 6), lane = tid & 63, l15 = lane & 15, fq = lane >> 4;
  const int kp = tid & 63, seg = wid, k0 = 2 * kp;
  const int N = S >> 6;
  const int cstart = dir ? 8 * seg + 7 : 8 * seg, cstep = dir ? -1 : 1;
  const unsigned* Fg = (const unsigned*)((const bf16_t*)(p.ws + (dir ? WS_FBW : WS_FFW)) + (size_t)T0 * 512 + hh * 128) + kp;
  const unsigned* Qg = (const unsigned*)((const bf16_t*)(p.ws + WS_QH) + (size_t)T0 * 512 + hh * 128) + kp;
  const bf16_t* Vg = (const bf16_t*)(p.ws + WS_IHT) + (size_t)T0 * 512 + (size_t)(hh * 128) * S;
  bf16_t* Od = (bf16_t*)p.out + (size_t)dir * NTOK * 512 + (size_t)T0 * 512 + hh * 128 + wid * 16 + fq * 4;
  f32x4 St[8];
#pragma unroll
  for (int i = 0; i < 8; ++i) St[i] = (f32x4){0.f, 0.f, 0.f, 0.f};
  unsigned fraw[8], qraw[8];
  const char* vsrc[2];
#pragma unroll
  for (int i = 0; i < 2; ++i) { const int R = 8 * (2 * wid + i) + (lane >> 3), g = (lane & 7) ^ ((R >> 1) & 7); vsrc[i] = (const char*)(Vg + (size_t)R * S) + g * 16; }
#define HG_LOAD(n, vb) do { const int _t0 = (n) * 64; \
    _Pragma("unroll") for (int j = 0; j < 8; ++j) { const size_t _o = (size_t)(_t0 + cstart + j * cstep) * 256; fraw[j] = Fg[_o]; qraw[j] = Qg[_o]; } \
    _Pragma("unroll") for (int i = 0; i < 2; ++i) __builtin_amdgcn_global_load_lds((const unsigned*)(vsrc[i] + (size_t)_t0 * 2), (LAS unsigned*)(lds + HG_VT + (vb) * 16384 + (2 * wid + i) * 1024), 16, 0, 0); } while (0)
  __syncthreads();
  HG_LOAD(dir ? N - 1 : 0, 0);
  const int vrd = (16 * wid + l15) * 128;
  const int swv = (l15 >> 1) & 7;
  for (int it = 0; it < N; ++it) {
    const int n = dir ? N - 1 - it : it, t0 = n * 64;
    float lf0[8], lf1[8], gk0[8], gk1[8];
    float run0 = 0.f, run1 = 0.f;
#pragma unroll
    for (int j = 0; j < 8; ++j) {
      const float f0 = f16lo(fraw[j]), f1 = f16hi(fraw[j]);
      gk0[j] = 1.f - __expf(f0); gk1[j] = 1.f - __expf(f1);
      run0 += f0; run1 += f1; lf0[j] = run0; lf1[j] = run1;
    }
    { float2 rr; rr.x = run0; rr.y = run1; *(float2*)(shm_raw + HG_SEG + (seg * 128 + k0) * 4) = rr; }
    __syncthreads();
    float off0 = 0.f, off1 = 0.f, bl0 = 0.f, bl1 = 0.f;
#pragma unroll
    for (int s2 = 0; s2 < 8; ++s2) {
      const float2 tt = *(const float2*)(shm_raw + HG_SEG + (s2 * 128 + k0) * 4);
      bl0 += tt.x; bl1 += tt.y;
      const bool before = dir ? (s2 > seg) : (s2 < seg);
      off0 += before ? tt.x : 0.f; off1 += before ? tt.y : 0.f;
    }
    float ks0[8], ks1[8];
#pragma unroll
    for (int j = 0; j < 8; ++j) {
      const float b0 = lf0[j] + off0, b1 = lf1[j] + off1;
      const float q0 = __uint_as_float(qraw[j] << 16), q1 = __uint_as_float(qraw[j] & 0xffff0000u);
      const int c = cstart + j * cstep;
      *(unsigned*)(shm_raw + HG_QT + c * 272 + k0 * 2) = pk_bf16(q0 * __expf(b0), q1 * __expf(b1));
      *(unsigned*)(shm_raw + HG_KT + c * 272 + k0 * 2) = pk_bf16(gk0[j] * __expf(-b0), gk1[j] * __expf(-b1));
      ks0[j] = gk0[j] * __expf(bl0 - b0); ks1[j] = gk1[j] * __expf(bl1 - b1);
    }
    {
      uint4 w0, w1;
      w0.x = pk_bf16(dir ? ks0[7] : ks0[0], dir ? ks0[6] : ks0[1]); w0.y = pk_bf16(dir ? ks0[5] : ks0[2], dir ? ks0[4] : ks0[3]);
      w0.z = pk_bf16(dir ? ks0[3] : ks0[4], dir ? ks0[2] : ks0[5]); w0.w = pk_bf16(dir ? ks0[1] : ks0[6], dir ? ks0[0] : ks0[7]);
      w1.x = pk_bf16(dir ? ks1[7] : ks1[0], dir ? ks1[6] : ks1[1]); w1.y = pk_bf16(dir ? ks1[5] : ks1[2], dir ? ks1[4] : ks1[3]);
      w1.z = pk_bf16(dir ? ks1[3] : ks1[4], dir ? ks1[2] : ks1[5]); w1.w = pk_bf16(dir ? ks1[1] : ks1[6], dir ? ks1[0] : ks1[7]);
      *(uint4*)(shm_raw + HG_KST + k0 * 144 + seg * 16) = w0;
      *(uint4*)(shm_raw + HG_KST + (k0 + 1) * 144 + seg * 16) = w1;
    }
    if (seg == 0) { float2 dd; dd.x = __expf(bl0); dd.y = __expf(bl1); *(float2*)(shm_raw + HG_DEC + k0 * 4) = dd; }
    PG8_WAIT_V(0);
    __syncthreads();
    if (it + 1 < N) HG_LOAD(dir ? N - 2 - it : it + 1, (it + 1) & 1);
    {
      const int sb = wid >> 1;
#pragma unroll
      for (int cbi = 0; cbi < 2; ++cbi) {
        const int cb = (wid & 1) * 2 + cbi;
        f32x4 acc = (f32x4){0.f, 0.f, 0.f, 0.f};
#pragma unroll
        for (int ks = 0; ks < 4; ++ks) {
          const bf16x8 A = *(const LAS bf16x8*)(lds + HG_KT + (16 * sb + l15) * 272 + ks * 64 + fq * 16);
          const bf16x8 B = *(const LAS bf16x8*)(lds + HG_QT + (16 * cb + l15) * 272 + ks * 64 + fq * 16);
          acc = MFMA16(A, B, acc);
        }
        const int s0 = 16 * sb + 4 * fq, cc = 16 * cb + l15;
        float m[4];
#pragma unroll
        for (int e = 0; e < 4; ++e) { const bool keep = dir ? (s0 + e >= cc) : (s0 + e <= cc); m[e] = keep ? acc[e] : 0.f; }
        uint2 q; q.x = pk_bf16(m[0], m[1]); q.y = pk_bf16(m[2], m[3]);
        *(uint2*)(shm_raw + HG_AM + cc * 144 + s0 * 2) = q;
      }
    }
    __syncthreads();
    bf16x8 vf[2];
#pragma unroll
    for (int st = 0; st < 2; ++st) vf[st] = *(const LAS bf16x8*)(lds + HG_VT + (it & 1) * 16384 + vrd + (((4 * st + fq) ^ swv) << 4));
    bf16x8 Sb[4];
#pragma unroll
    for (int m = 0; m < 4; ++m) {
      u32x4 pk;
      pk[0] = pk_bf16(St[2 * m][0], St[2 * m][1]); pk[1] = pk_bf16(St[2 * m][2], St[2 * m][3]);
      pk[2] = pk_bf16(St[2 * m + 1][0], St[2 * m + 1][1]); pk[3] = pk_bf16(St[2 * m + 1][2], St[2 * m + 1][3]);
      Sb[m] = __builtin_bit_cast(bf16x8, pk);
    }
#pragma unroll
    for (int cb = 0; cb < 4; ++cb) {
      f32x4 acc = (f32x4){0.f, 0.f, 0.f, 0.f};
#pragma unroll
      for (int st = 0; st < 2; ++st) {
        const bf16x8 B = *(const LAS bf16x8*)(lds + HG_AM + (16 * cb + l15) * 144 + st * 64 + fq * 16);
        acc = MFMA16(vf[st], B, acc);
      }
#pragma unroll
      for (int m = 0; m < 4; ++m) {
        const s16x4 lo = *(const LAS s16x4*)(lds + HG_QT + (16 * cb + l15) * 272 + (32 * m + 4 * fq) * 2);
        const s16x4 hi = *(const LAS s16x4*)(lds + HG_QT + (16 * cb + l15) * 272 + (32 * m + 16 + 4 * fq) * 2);
        const bf16x8 B = __builtin_shufflevector(lo, hi, 0, 1, 2, 3, 4, 5, 6, 7);
        acc = MFMA16(Sb[m], B, acc);
      }
      uint2 o; o.x = pk_bf16(acc[0], acc[1]); o.y = pk_bf16(acc[2], acc[3]);
      *(uint2*)(Od + (size_t)(t0 + 16 * cb + l15) * 512) = o;
    }
#pragma unroll
    for (int kb = 0; kb < 8; ++kb) {
      const float4 dc = *(const float4*)(shm_raw + HG_DEC + (16 * kb + 4 * fq) * 4);
      f32x4 s = St[kb];
      s[0] *= dc.x; s[1] *= dc.y; s[2] *= dc.z; s[3] *= dc.w;
#pragma unroll
      for (int st = 0; st < 2; ++st) {
        const bf16x8 A = *(const LAS bf16x8*)(lds + HG_KST + (16 * kb + l15) * 144 + st * 64 + fq * 16);
        s = MFMA16(A, vf[st], s);
      }
      St[kb] = s;
    }
    __syncthreads();
  }
#undef HG_LOAD
}

DI void phase_mixer(const Params& p) {
  extern __shared__ __attribute__((aligned(16))) char shm_raw[];
  int* sItem = (int*)(shm_raw + 131072 + 2048);
  unsigned* ctr = (unsigned*)(p.ws + WS_END);
  for (;;) {
    __syncthreads();
    if (threadIdx.x == 0) *sItem = (int)atomicAdd(ctr, 1u);
    __syncthreads();
    const int it = *sItem;
    if (it >= 48 + 2048) break;
    if (it < 48) hgrn_item(p, it); else attn_item(p, it - 48);
  }
}

DI void phase_combine(const Params& p) {
  const int lane = threadIdx.x & 63, wave = threadIdx.x >> 6;
  const unsigned* ofw = (const unsigned*)p.out; const unsigned* obw = (const unsigned*)((const bf16_t*)p.out + (size_t)NTOK * 512);
  const unsigned* GH = (const unsigned*)(p.ws + WS_GH);
  bf16_t* OC = (bf16_t*)(p.ws + WS_OCAT);
  const float w0 = p.hgrn_norm_w[lane * 2], w1 = p.hgrn_norm_w[lane * 2 + 1];
  for (int tok = blockIdx.x * 8 + wave; tok < NTOK; tok += gridDim.x * 8) {
    unsigned a[4], b[4], g[4];
#pragma unroll
    for (int hh = 0; hh < 4; ++hh) { const size_t idx = ((size_t)tok * 512 + hh * 128 + lane * 2) >> 1; a[hh] = ofw[idx]; b[hh] = obw[idx]; g[hh] = GH[idx]; }
#pragma unroll
    for (int hh = 0; hh < 4; ++hh) {
      const float o0 = __uint_as_float(a[hh] << 16) + __uint_as_float(b[hh] << 16), o1 = __uint_as_float(a[hh] & 0xffff0000u) + __uint_as_float(b[hh] & 0xffff0000u);
      const float ss = wave_sum(o0 * o0 + o1 * o1);
      const float rstd = rsqrtf(ss * (1.f / 128.f) + EPSN);
      const float g0 = __uint_as_float(g[hh] << 16), g1 = __uint_as_float(g[hh] & 0xffff0000u);
      *(unsigned*)(OC + (size_t)tok * 1024 + 512 + hh * 128 + lane * 2) = cvt_pk_bf16(o0 * rstd * w0 * g0, o1 * rstd * w1 * g1);
    }
  }
}

#define XB_TMO      128
#define XB_XCNT(j)  (256  + 64 * (j))
#define XB_XSUB(j)  (1280 + 64 * (j))
#define XB_XGEN(j)  (2304 + 64 * (j))
#define XB_TOP      3328
#define XB_TOPGEN   3392
#define XCD_BAR_WORDS 3456
#define XB_SPIN_CAP (1u << 20)
constexpr size_t WS_BAR = WS_END + 8192 + 262144 + 256;
DI unsigned xb_ld(unsigned* p)              { return __hip_atomic_load(p, __ATOMIC_RELAXED, __HIP_MEMORY_SCOPE_AGENT); }
DI unsigned xb_add(unsigned* p, unsigned v) { return __hip_atomic_fetch_add(p, v, __ATOMIC_RELAXED, __HIP_MEMORY_SCOPE_AGENT); }
DI unsigned xb_xcc_id() { return (unsigned)__builtin_amdgcn_s_getreg((3 << 11) | 20) & 0xFu; }
#define XB_SPIN(cond, bar) do { unsigned _sp = 0; while (cond) { __builtin_amdgcn_s_sleep(1); \
    if ((++_sp & 255u) == 0u) { if (xb_ld(&(bar)[XB_TMO])) break; if (_sp > XB_SPIN_CAP) { atomicAdd(&(bar)[XB_TMO], 1u); break; } } } } while (0)
struct XcdBarrier { unsigned* bar; unsigned x; volatile LAS unsigned* st; };
DI XcdBarrier xcd_barrier_post(unsigned* bar, volatile LAS unsigned* st) {
  XcdBarrier b; b.bar = bar; b.x = xb_xcc_id(); b.st = st;
  if (threadIdx.x == 0) (void)xb_add(&bar[XB_XCNT(b.x)], 1u);
  return b;
}
DI void xcd_barrier_complete(unsigned* bar, unsigned x, unsigned& nloc, unsigned& nx) {
  const unsigned G = gridDim.x * gridDim.y * gridDim.z;
  unsigned sum, cnt, mine, sp = 0u;
  for (;;) {
    sum = 0u; cnt = 0u; mine = 0u;
#pragma unroll
    for (unsigned j = 0; j < 16; ++j) { const unsigned c = xb_ld(&bar[XB_XCNT(j)]); sum += c; cnt += (c > 0u) ? 1u : 0u; mine = (j == x) ? c : mine; }
    if (sum == G) break;
    __builtin_amdgcn_s_sleep(1);
    if ((++sp & 255u) == 0u) { if (xb_ld(&bar[XB_TMO])) break; if (sp > XB_SPIN_CAP) { atomicAdd(&bar[XB_TMO], 1u); break; } }
  }
  nloc = mine > 0u ? mine : 1u; nx = cnt > 0u ? cnt : 1u;
}
DI void xcd_barrier(const XcdBarrier& b) {
  asm volatile("s_waitcnt vmcnt(0)" ::: "memory");
  __syncthreads();
  if (threadIdx.x == 0) {
    unsigned* bar = b.bar;
    __builtin_amdgcn_s_waitcnt(0);
    unsigned nloc = b.st[0], nx = b.st[1];
    if (nloc == 0u) { xcd_barrier_complete(bar, b.x, nloc, nx); b.st[0] = nloc; b.st[1] = nx; }
    const unsigned old = xb_add(&bar[XB_XSUB(b.x)], 1u);
    const unsigned gen = old / nloc;
    if (old + 1u == (gen + 1u) * nloc) {
      __builtin_amdgcn_fence(__ATOMIC_RELEASE, "agent");
      asm volatile("s_waitcnt vmcnt(0)" ::: "memory");
      const unsigned og = xb_add(&bar[XB_TOP], 1u);
      const unsigned tg = og / nx;
      if (og + 1u == (tg + 1u) * nx) xb_add(&bar[XB_TOPGEN], 1u);
      else XB_SPIN(xb_ld(&bar[XB_TOPGEN]) == tg, bar);
      __builtin_amdgcn_fence(__ATOMIC_ACQUIRE, "agent");
      xb_add(&bar[XB_XGEN(b.x)], 1u);
      asm volatile("s_waitcnt vmcnt(0)" ::: "memory");
    } else {
      XB_SPIN(xb_ld(&bar[XB_XGEN(b.x)]) == gen, bar);
      __builtin_amdgcn_fence(__ATOMIC_ACQUIRE, "agent");
      asm volatile("s_waitcnt vmcnt(0)" ::: "memory");
    }
  }
  __syncthreads();
}

template <int PH> DI void run_phase(const Params& p) {
  if constexpr (PH == 0) phase_prep(p);
  else if constexpr (PH == 1) phase_gemm<0>(p, (const bf16_t*)(p.ws + WS_H), (const bf16_t*)(p.ws + WS_WIN), 4096, 1024);
  else if constexpr (PH == 2) phase_mixer(p);
  else if constexpr (PH == 3) phase_combine(p);
  else if constexpr (PH == 4) phase_gemm<1>(p, (const bf16_t*)(p.ws + WS_OCAT), (const bf16_t*)(p.ws + WS_WOUT), 1024, 1024);
  else if constexpr (PH == 5) phase_norm2(p);
  else if constexpr (PH == 6) phase_gemm<2>(p, (const bf16_t*)(p.ws + WS_H), (const bf16_t*)(p.ws + WS_WM1), 4096, 1024);
  else if constexpr (PH == 7) phase_gemm<3>(p, (const bf16_t*)(p.ws + WS_BIG), (const bf16_t*)(p.ws + WS_WM2), 1024, 4096);
}
__global__ void __launch_bounds__(512, 2) mega(Params p) {
  extern __shared__ __attribute__((aligned(16))) char shm_raw[];
  cg::grid_group grid = cg::this_grid();
  volatile LAS unsigned* st = (volatile LAS unsigned*)((LAS unsigned char*)shm_raw + 131072 + 3072);
  if (threadIdx.x == 0) { st[0] = 0u; st[1] = 0u; st[2] = 0u; st[3] = 0u; }
  __syncthreads();
  if (p.ph_hi < 0) grid.sync();
  const XcdBarrier xb = xcd_barrier_post((unsigned*)(p.ws + WS_BAR), st);
  run_phase<0>(p); xcd_barrier(xb);
  run_phase<1>(p); xcd_barrier(xb);
  run_phase<2>(p); xcd_barrier(xb);
  run_phase<3>(p); xcd_barrier(xb);
  run_phase<4>(p); xcd_barrier(xb);
  run_phase<6>(p); xcd_barrier(xb);
  run_phase<7>(p);
}

extern "C" void kernel_launch(void* const* d_in, const int* in_sizes, int n_in, void* d_out, int out_size, void* d_ws, size_t ws_size, hipStream_t stream) {
  static int grid_blocks = 0;
  if (!grid_blocks) {
    int dev = 0, cus = 0, per_cu = 0;
    (void)hipGetDevice(&dev);
    (void)hipDeviceGetAttribute(&cus, hipDeviceAttributeMultiprocessorCount, dev);
    (void)hipFuncSetAttribute((const void*)mega, hipFuncAttributeMaxDynamicSharedMemorySize, LDS_BYTES);
    (void)hipOccupancyMaxActiveBlocksPerMultiprocessor(&per_cu, (const void*)mega, 512, LDS_BYTES);
    if (per_cu < 1) per_cu = 1;
    grid_blocks = cus * per_cu;
    if (grid_blocks > 256) grid_blocks = 256;
    if (grid_blocks < 256) fprintf(stderr, "expected 256 co-resident workgroups, got %d\n", grid_blocks);
    if (ws_size < WS_END + 8192 + 262144 + 32768) fprintf(stderr, "workspace too small: %zu < %zu\n", ws_size, (size_t)WS_END);
  }
  Params p{};
  p.xp = (const float*)d_in[0]; p.xs = (const float*)d_in[1]; p.attn_norm_w = (const float*)d_in[2]; p.w_in = (const float*)d_in[3];
  p.qk_norm_w = (const float*)d_in[4]; p.diff_lambda = (const float*)d_in[5]; p.diff_subln_w = (const float*)d_in[6]; p.rel_bias = (const float*)d_in[7];
  p.hgrn_lb = (const float*)d_in[8]; p.hgrn_norm_w = (const float*)d_in[9]; p.w_out = (const float*)d_in[10]; p.mlp_norm_w = (const float*)d_in[11];
  p.w_mlp_in = (const float*)d_in[12]; p.w_mlp_out = (const float*)d_in[13];
  p.out = (float*)d_out; p.ws = (unsigned char*)d_ws;
  p.ph_lo = 0; p.ph_hi = 7;
  (void)hipMemsetAsync((unsigned char*)d_ws + WS_BAR, 0, XCD_BAR_WORDS * 4, stream);
  void* args[] = {&p};
  hipError_t e = hipLaunchCooperativeKernel((const void*)mega, dim3(grid_blocks), dim3(512), args, LDS_BYTES, stream);
  if (e != hipSuccess) fprintf(stderr, "cooperative launch failed: %s (grid %d)\n", hipGetErrorString(e), grid_blocks);
}
```
